# Optimizing an MI355X kernel written in HIP

```python
import jax, jax.numpy as jnp
from jax import lax
import numpy as np

D_MODEL = 2048
BATCH = 1
SEQ = 8192
DEPTH = 2

N_MIXERS = 2
N_RET_LAYERS = (DEPTH + 1) // 2
N_ATT_LAYERS = DEPTH // 2

RET_HEADS = 8
RET_QK_DIM = D_MODEL // RET_HEADS
RET_V_DIM = 2 * D_MODEL // RET_HEADS
RET_CHUNK = 128
RET_IN_DIM = 2 * RET_HEADS * RET_QK_DIM + 2 * RET_HEADS * RET_V_DIM

ATT_HEAD_DIM = 64
ATT_HEADS = D_MODEL // ATT_HEAD_DIM
ATT_KV_HEADS = ATT_HEADS // 8
ATT_GROUP = ATT_HEADS // ATT_KV_HEADS
WINDOW = 128
ATT_BLOCK = 128
ATT_IN_DIM = (ATT_HEADS + 2 * ATT_KV_HEADS) * ATT_HEAD_DIM

D_FF = ((8 * D_MODEL // 3 + 127) // 128) * 128
CONV_WIDTH = 3

EPS = 1e-6

kernel_name = "hybrid_retention_swa_sink_convffn"


def rmsnorm(x, g):
    xf = x.astype(jnp.float32)
    y = xf * lax.rsqrt(jnp.mean(xf * xf, axis=-1, keepdims=True) + EPS)
    return (y * g.astype(jnp.float32)).astype(x.dtype)


def retention(h, w_in, w_out):
    B, S, _ = h.shape
    H, dk, dv, C = RET_HEADS, RET_QK_DIM, RET_V_DIM, RET_CHUNK
    nc = S // C
    proj = h @ w_in
    q, k, v, g = jnp.split(proj, [H * dk, 2 * H * dk, 2 * H * dk + H * dv], axis=-1)

    def to_chunks(t, d):
        return t.reshape(B, nc, C, H, d).transpose(1, 0, 3, 2, 4)

    q = to_chunks(q, dk)
    k = to_chunks(k, dk) * (dk ** -0.5)
    v = to_chunks(v, dv)

    log_gamma = jnp.log1p(-(2.0 ** (-5.0 - jnp.arange(H, dtype=jnp.float32))))
    n = jnp.arange(C, dtype=jnp.float32)
    diff = n[:, None] - n[None, :]
    intra = jnp.where(diff >= 0, jnp.exp(log_gamma[:, None, None] * jnp.maximum(diff, 0.0)), 0.0)
    q_decay = jnp.exp(log_gamma[:, None] * (n + 1.0))[..., None]
    k_decay = jnp.exp(log_gamma[:, None] * (C - 1.0 - n))[..., None]
    chunk_decay = jnp.exp(log_gamma * C)[:, None, None]

    def step(state, qkv):
        qc, kc, vc = qkv
        scores = jnp.einsum('bhnd,bhmd->bhnm', qc, kc) * intra
        o = (jnp.einsum('bhnm,bhme->bhne', scores, vc)
             + jnp.einsum('bhnd,bhde->bhne', qc * q_decay, state))
        state = state * chunk_decay + jnp.einsum('bhmd,bhme->bhde', kc * k_decay, vc)
        return state, o

    state0 = jnp.zeros((B, H, dk, dv), jnp.float32)
    _, o = lax.scan(step, state0, (q, k, v))
    o = o.transpose(1, 0, 3, 2, 4).reshape(B, S, H, dv).astype(jnp.float32)
    o = o * lax.rsqrt(jnp.mean(o * o, axis=-1, keepdims=True) + EPS)
    y = jax.nn.silu(g.astype(jnp.float32)) * o.reshape(B, S, H * dv)
    return y.astype(h.dtype) @ w_out


def sliding_window_attention(h, w_qkv, b_qkv, sinks, w_out):
    B, S, _ = h.shape
    Hq, Hkv, G, dh, BLK = ATT_HEADS, ATT_KV_HEADS, ATT_GROUP, ATT_HEAD_DIM, ATT_BLOCK
    nb = S // BLK
    proj = h @ w_qkv + b_qkv
    q, k, v = jnp.split(proj, [Hq * dh, (Hq + Hkv) * dh], axis=-1)
    q = q.reshape(B, nb, BLK, Hkv, G, dh)
    k = k.reshape(B, nb, BLK, Hkv, dh)
    v = v.reshape(B, nb, BLK, Hkv, dh)
    pad = ((0, 0), (1, 0), (0, 0), (0, 0), (0, 0))
    kb = jnp.concatenate([jnp.pad(k, pad)[:, :-1], k], axis=2)
    vb = jnp.concatenate([jnp.pad(v, pad)[:, :-1], v], axis=2)

    scores = jnp.einsum('bnqhgd,bnkhd->bnhgqk', q, kb).astype(jnp.float32) * (dh ** -0.5)
    qpos = jnp.arange(BLK) + BLK
    kpos = jnp.arange(2 * BLK)
    dist = qpos[:, None] - kpos[None, :]
    in_window = (dist >= 0) & (dist < WINDOW)
    blk = jnp.arange(nb)
    valid = in_window[None] & ((blk[:, None, None] > 0) | (kpos[None, None, :] >= BLK))
    slopes = (2.0 ** (-8.0 * jnp.arange(1, Hq + 1, dtype=jnp.float32) / Hq)).reshape(Hkv, G)
    scores = scores - slopes[:, :, None, None] * dist.astype(jnp.float32)
    scores = jnp.where(valid[None, :, None, None], scores, -jnp.inf)
    sink = jnp.broadcast_to(sinks.astype(jnp.float32).reshape(Hkv, G)[None, None, :, :, None, None],
                            scores.shape[:-1] + (1,))
    probs = jax.nn.softmax(jnp.concatenate([scores, sink], axis=-1), axis=-1)[..., :-1]
    out = jnp.einsum('bnhgqk,bnkhd->bnqhgd', probs.astype(vb.dtype), vb)
    return out.reshape(B, S, Hq * dh) @ w_out


def conv_ffn(h, w_up, conv_w, conv_b, w_down):
    S = h.shape[1]
    u = h @ w_up
    up = jnp.pad(u, ((0, 0), (CONV_WIDTH - 1, 0), (0, 0)))
    c = conv_b + sum(up[:, j:j + S] * conv_w[j] for j in range(CONV_WIDTH))
    a, b = jnp.split(c, 2, axis=-1)
    return (jax.nn.silu(a) * b) @ w_down


def setup_inputs(seed: int = 0) -> dict:
    key = jax.random.key(seed)
    ks = jax.random.split(key, 14)
    f32 = jnp.float32

    def dense(k, shape, fan_in):
        return jax.random.normal(k, shape, f32) * (fan_in ** -0.5)

    def gain(k, shape):
        return 1.0 + 0.02 * jax.random.normal(k, shape, f32)

    NR, NA = N_RET_LAYERS, N_ATT_LAYERS
    return {
        "x": jax.random.normal(ks[0], (BATCH, SEQ, D_MODEL), f32),
        "norm_mix_g": gain(ks[1], (DEPTH, D_MODEL)),
        "ret_w_in": dense(ks[2], (NR, D_MODEL, RET_IN_DIM), D_MODEL),
        "ret_w_out": dense(ks[3], (NR, RET_HEADS * RET_V_DIM, D_MODEL), RET_HEADS * RET_V_DIM),
        "att_w_qkv": dense(ks[4], (NA, D_MODEL, ATT_IN_DIM), D_MODEL),
        "att_b_qkv": 0.02 * jax.random.normal(ks[5], (NA, ATT_IN_DIM), f32),
        "att_sinks": jax.random.normal(ks[6], (NA, ATT_HEADS), f32),
        "att_w_out": dense(ks[7], (NA, ATT_HEADS * ATT_HEAD_DIM, D_MODEL), ATT_HEADS * ATT_HEAD_DIM),
        "norm_ffn_g": gain(ks[8], (DEPTH, D_MODEL)),
        "ffn_w_up": dense(ks[9], (DEPTH, D_MODEL, 2 * D_FF), D_MODEL),
        "ffn_conv_w": dense(ks[10], (DEPTH, CONV_WIDTH, 2 * D_FF), CONV_WIDTH),
        "ffn_conv_b": 0.02 * jax.random.normal(ks[11], (DEPTH, 2 * D_FF), f32),
        "ffn_w_down": dense(ks[12], (DEPTH, D_FF, D_MODEL), D_FF),
        "final_norm_g": gain(ks[13], (D_MODEL,)),
    }


def reference(x, norm_mix_g, ret_w_in, ret_w_out, att_w_qkv, att_b_qkv, att_sinks, att_w_out,
              norm_ffn_g, ffn_w_up, ffn_conv_w, ffn_conv_b, ffn_w_down, final_norm_g):
    h = x
    for i in range(DEPTH):
        j = i // N_MIXERS
        hn = rmsnorm(h, norm_mix_g[i])
        if i % N_MIXERS == 0:
            h = h + retention(hn, ret_w_in[j], ret_w_out[j])
        else:
            h = h + sliding_window_attention(hn, att_w_qkv[j], att_b_qkv[j], att_sinks[j], att_w_out[j])
        hn = rmsnorm(h, norm_ffn_g[i])
        h = h + conv_ffn(hn, ffn_w_up[i], ffn_conv_w[i], ffn_conv_b[i], ffn_w_down[i])
    return rmsnorm(h, final_norm_g)
```

```cpp
#include <hip/hip_runtime.h>
#include <hip/hip_cooperative_groups.h>
#include <cstdio>
#include <cstdint>
#include <cmath>
namespace cg = cooperative_groups;
namespace pg8 {
#define PG8_LAS __attribute__((address_space(3)))
typedef unsigned short bf16_t;
typedef short bf16x8 __attribute__((ext_vector_type(8)));
typedef float f32x4 __attribute__((ext_vector_type(4)));
typedef unsigned u32x4 __attribute__((ext_vector_type(4)));
constexpr int BM = 256, BK = 64, HALF = 128, HTB = HALF * BK * 2  , STAGE_BYTES = 8 * HTB, NXCD = 8, WGM = 8;

__host__ __device__ __forceinline__ int lds_byte(int r, int c) { const int st = (r >> 4) * 2 + (c >> 5), rr = r & 15, cc = c & 31, ob = rr * 64 + cc * 2; return st * 1024 + (ob ^ (((ob >> 9) & 1) << 5)); }
__host__ __device__ __forceinline__ void stage_rc(int b, int& R, int& C) { const int st = b / 1024, sb = b % 1024, swz = sb ^ (((sb >> 9) & 1) << 5); R = (st >> 1) * 16 + swz / 64; C = (st & 1) * 32 + (swz % 64) / 2; }
__host__ __device__ __forceinline__ int perm32(int rho) { const int n = rho >> 4, i = rho & 15; return 8 * (i >> 2) + 4 * n + (i & 3); }

struct Unit { int pm, pn; };
struct Gemm { const bf16_t* A; const bf16_t* Bt; int M, N, K; int arows = 256; };

struct StaticOrder {
    int nM, nN, nwg, G, c;
    __host__ __device__ void init(int M, int N, int G_, int c_) { nM = M / BM; nN = N / BM; nwg = nM * nN; G = G_; c = c_; }
    __host__ __device__ bool next(int i, Unit& u) const {
        const long L = (long)i * G + c; if (L >= nwg) return false;
        int wgid = (int)L; { const int q = nwg / NXCD, r = nwg % NXCD, xcd = wgid % NXCD, off = wgid / NXCD; wgid = (xcd < r ? xcd * (q + 1) : r * (q + 1) + (xcd - r) * q) + off; }
        const int nig = WGM * nN, gid = wgid / nig, fm = gid * WGM, gsz = (nM - fm) < WGM ? (nM - fm) : WGM;
        u.pm = fm + ((wgid % nig) % gsz); u.pn = (wgid % nig) / gsz; return true;
    }
    __device__ __forceinline__ void a_ready(const Unit&) const {}
    __device__ __forceinline__ void done(const Unit&) const {}
};
__device__ __forceinline__ unsigned cvt_pk_bf16(float lo, float hi) { unsigned r; asm volatile("v_cvt_pk_bf16_f32 %0, %1, %2" : "=v"(r) : "v"(lo), "v"(hi)); return r; }
typedef float f32x2 __attribute__((ext_vector_type(2)));
__device__ __forceinline__ float row_rstd(const float* ss, int row) {
    const f32x4 a = *(const f32x4*)(ss + (size_t)row * 8), b = *(const f32x4*)(ss + (size_t)row * 8 + 4);
    const float s = ((a[0] + a[1]) + (a[2] + a[3])) + ((b[0] + b[1]) + (b[2] + b[3]));
    return 1.0f / sqrtf(s * (1.0f / 2048.0f) + 1e-6f);
}
struct EpiScale {
    static constexpr bool PERM = true, AFTER_DRAIN = false, KHOOK = false;
    bf16_t* O; int ldc; const float* ss; const float* bias; int mode;
    __device__ __forceinline__ void operator()(const f32x4 (&acc)[2][2][4][2], const Unit& u, int wr, int wc, int fr, int fq, PG8_LAS unsigned char* lds, int wid, int lane) const {
        const int colt = u.pn * BM; const int col0 = colt + wc * 32 + 8 * fq;
        PG8_LAS float* tbl = (PG8_LAS float*)(lds + 131072 + 10240);
        PG8_LAS unsigned char* st = lds + 131072 + wid * 1280;
        { const int t = wid * 64 + lane; if (t < 256) tbl[t] = row_rstd(ss, u.pm * BM + t); }
        f32x4 bv[2][2];
#pragma unroll
        for (int bj = 0; bj < 2; ++bj)
#pragma unroll
            for (int n = 0; n < 2; ++n) bv[bj][n] = bias ? *(const f32x4*)(bias + col0 + bj * HALF + 4 * n) : (f32x4){0.f, 0.f, 0.f, 0.f};
        const float cs = (mode == 2 && colt < 2048) ? 0.125f : 1.0f;
        asm volatile("s_waitcnt lgkmcnt(0)" ::: "memory"); __builtin_amdgcn_s_barrier(); asm volatile("" ::: "memory");
        bf16_t* obase = O + (size_t)(u.pm * BM + wr * 64 + (lane >> 2)) * ldc + colt + wc * 32 + 8 * (lane & 3);
#pragma unroll
        for (int ai = 0; ai < 2; ++ai)
#pragma unroll
            for (int m = 0; m < 4; ++m) { const float rs = tbl[ai * HALF + wr * 64 + m * 16 + fr];
#pragma unroll
                for (int bj = 0; bj < 2; ++bj) { const f32x4 v0 = (acc[ai][bj][m][0] * rs + bv[bj][0]) * cs, v1 = (acc[ai][bj][m][1] * rs + bv[bj][1]) * cs;
                    u32x4 w; w.x = cvt_pk_bf16(v0[0], v0[1]); w.y = cvt_pk_bf16(v0[2], v0[3]); w.z = cvt_pk_bf16(v1[0], v1[1]); w.w = cvt_pk_bf16(v1[2], v1[3]);
                    *(PG8_LAS u32x4*)(st + fr * 80 + fq * 16) = w;
                    const u32x4 x = *(const PG8_LAS u32x4*)(st + (lane >> 2) * 80 + (lane & 3) * 16);
                    *(u32x4*)(obase + (size_t)(ai * HALF + m * 16) * ldc + bj * HALF) = x; } }
    }
};
struct EpiScaleT {
    static constexpr bool PERM = true, AFTER_DRAIN = false, KHOOK = false;
    bf16_t* O; int ldc; const float* ss;
    __device__ __forceinline__ void operator()(const f32x4 (&acc)[2][2][4][2], const Unit& u, int wr, int wc, int fr, int fq, PG8_LAS unsigned char* lds, int wid, int lane) const {
        PG8_LAS float* tbl = (PG8_LAS float*)(lds + 131072 + 10240);
        PG8_LAS unsigned char* st = lds + 131072 + wid * 1280;
        { const int t = wid * 64 + lane; if (t < 256) { const int col = u.pn * BM + t; float r = row_rstd(ss, col);
            if (u.pm < 8) { const float lg = -log2f(1.0f - exp2f(-5.0f - (float)u.pm)); r *= exp2f(lg * (float)((col & 127) + 1)) * 0.0625f; } tbl[t] = r; } }
        asm volatile("s_waitcnt lgkmcnt(0)" ::: "memory"); __builtin_amdgcn_s_barrier(); asm volatile("" ::: "memory");
        f32x4 cr[2][2];
#pragma unroll
        for (int bj = 0; bj < 2; ++bj)
#pragma unroll
            for (int n = 0; n < 2; ++n) cr[bj][n] = *(const PG8_LAS f32x4*)(tbl + bj * HALF + wc * 32 + 8 * fq + 4 * n);
        bf16_t* obase = O + (size_t)(u.pm * BM + wr * 64 + (lane >> 2)) * ldc + u.pn * BM + wc * 32 + 8 * (lane & 3);
#pragma unroll
        for (int ai = 0; ai < 2; ++ai)
#pragma unroll
            for (int m = 0; m < 4; ++m) {
#pragma unroll
                for (int bj = 0; bj < 2; ++bj) { const f32x4 v0 = acc[ai][bj][m][0] * cr[bj][0], v1 = acc[ai][bj][m][1] * cr[bj][1];
                    u32x4 w; w.x = cvt_pk_bf16(v0[0], v0[1]); w.y = cvt_pk_bf16(v0[2], v0[3]); w.z = cvt_pk_bf16(v1[0], v1[1]); w.w = cvt_pk_bf16(v1[2], v1[3]);
                    *(PG8_LAS u32x4*)(st + fr * 80 + fq * 16) = w;
                    const u32x4 x = *(const PG8_LAS u32x4*)(st + (lane >> 2) * 80 + (lane & 3) * 16);
                    *(u32x4*)(obase + (size_t)(ai * HALF + m * 16) * ldc + bj * HALF) = x; } }
    }
};
#define PG8_ROR(src, ctrl) __builtin_bit_cast(float, __builtin_amdgcn_mov_dpp(__builtin_bit_cast(int, (float)(src)), (ctrl), 0xf, 0xf, true))
#define PG8_DPP(old, src, ctrl) __builtin_bit_cast(float, __builtin_amdgcn_update_dpp(__builtin_bit_cast(int, (float)(old)), __builtin_bit_cast(int, (float)(src)), (ctrl), 0xf, 0xf, false))
struct EpiConv {
    static constexpr bool PERM = true, AFTER_DRAIN = false, KHOOK = false;
    bf16_t* HM; const float* ss; const float* cw; const float* cb;
    __device__ __forceinline__ void operator()(f32x4 (&acc)[2][2][4][2], const Unit& u, int wr, int wc, int fr, int fq, PG8_LAS unsigned char* lds, int wid, int lane) const {
        PG8_LAS float* tbl = (PG8_LAS float*)(lds + 131072 + 10240);
        PG8_LAS unsigned char* st = lds + 131072 + wid * 1280;
        PG8_LAS float* X = (PG8_LAS float*)(lds + 131072 + 11264);
        const int grow0 = 254 * u.pm - 2;
        { const int t = wid * 64 + lane; if (t < 256) { const int gr = grow0 + t; tbl[t] = (gr >= 0 && gr < 8192) ? row_rstd(ss, gr) : 0.f; } }
        const int j0 = u.pn * 128 + wc * 32 + 8 * fq;
        asm volatile("s_waitcnt lgkmcnt(0)" ::: "memory"); __builtin_amdgcn_s_barrier(); asm volatile("" ::: "memory");
#pragma unroll
        for (int ai = 0; ai < 2; ++ai)
#pragma unroll
            for (int m = 0; m < 4; ++m) { const float rs = tbl[ai * HALF + wr * 64 + m * 16 + fr];
#pragma unroll
                for (int bj = 0; bj < 2; ++bj)
#pragma unroll
                    for (int n = 0; n < 2; ++n) acc[ai][bj][m][n] = acc[ai][bj][m][n] * rs; }
        if (fr >= 14) {
#pragma unroll
            for (int ai = 0; ai < 2; ++ai) { const int b = 2 * ai + wr; if (b < 3) {
#pragma unroll
                for (int bj = 0; bj < 2; ++bj)
#pragma unroll
                    for (int n = 0; n < 2; ++n) *(PG8_LAS f32x4*)(X + (b * 2 + fr - 14) * 256 + bj * HALF + wc * 32 + 8 * fq + 4 * n) = acc[ai][bj][3][n]; } }
        }
        asm volatile("s_waitcnt lgkmcnt(0)" ::: "memory"); __builtin_amdgcn_s_barrier(); asm volatile("" ::: "memory");
        unsigned pk0[2][4][2];
#pragma unroll
        for (int n = 0; n < 2; ++n) {
            f32x4 w[2][3], bs[2];
#pragma unroll
            for (int bj = 0; bj < 2; ++bj) {
#pragma unroll
                for (int k = 0; k < 3; ++k) w[bj][k] = *(const f32x4*)(cw + k * 11008 + bj * 5504 + j0 + 4 * n);
                bs[bj] = *(const f32x4*)(cb + bj * 5504 + j0 + 4 * n); }
#pragma unroll
            for (int ai = 0; ai < 2; ++ai) { const int b = 2 * ai + wr;
#pragma unroll
                for (int m = 0; m < 4; ++m) { f32x4 c[2];
#pragma unroll
                    for (int bj = 0; bj < 2; ++bj) { const f32x4 cur = acc[ai][bj][m][n]; f32x4 prev;
                        if (m > 0) prev = acc[ai][bj][m > 0 ? m - 1 : 0][n];
                        else { prev = (f32x4){0.f, 0.f, 0.f, 0.f}; if (b > 0 && fr >= 14) prev = *(const PG8_LAS f32x4*)(X + ((b - 1) * 2 + fr - 14) * 256 + bj * HALF + wc * 32 + 8 * fq + 4 * n); }
                        f32x4 p1, p2;
#pragma unroll
                        for (int j = 0; j < 4; ++j) { const float r1 = PG8_ROR(prev[j], 0x121), r2 = PG8_ROR(prev[j], 0x122);
                            p1[j] = PG8_DPP(r1, cur[j], 0x111); p2[j] = PG8_DPP(r2, cur[j], 0x112); }
                        c[bj] = bs[bj] + w[bj][0] * p2 + w[bj][1] * p1 + w[bj][2] * cur; }
                    float h4[4];
#pragma unroll
                    for (int j = 0; j < 4; ++j) h4[j] = c[0][j] * __builtin_amdgcn_rcpf(1.0f + __expf(-c[0][j])) * c[1][j];
                    if (n == 0) { pk0[ai][m][0] = cvt_pk_bf16(h4[0], h4[1]); pk0[ai][m][1] = cvt_pk_bf16(h4[2], h4[3]); }
                    else { u32x4 pk; pk.x = pk0[ai][m][0]; pk.y = pk0[ai][m][1]; pk.z = cvt_pk_bf16(h4[0], h4[1]); pk.w = cvt_pk_bf16(h4[2], h4[3]);
                        *(PG8_LAS u32x4*)(st + fr * 80 + fq * 16) = pk;
                        const u32x4 x = *(const PG8_LAS u32x4*)(st + (lane >> 2) * 80 + (lane & 3) * 16);
                        const int t2 = ai * HALF + wr * 64 + m * 16 + (lane >> 2), gr = grow0 + t2;
                        if (t2 >= 2 && gr < 8192) *(u32x4*)(HM + (size_t)gr * 5504 + u.pn * 128 + wc * 32 + 8 * (lane & 3)) = x; } } }
            asm volatile("" ::: "memory");
        }
    }
};
struct EpiResid {
    static constexpr bool PERM = true, AFTER_DRAIN = true, KHOOK = false;
    bf16_t* xb; float* ss; int ldc;
    __device__ __forceinline__ void fused(f32x4 (&acc)[2][2][4][2], const Unit& u, int wr, int wc, int fr, int fq, PG8_LAS unsigned char* lds, int wid, int lane) const {
        PG8_LAS float* P = (PG8_LAS float*)lds;
        const int col0 = u.pn * BM + wc * 32 + 8 * fq;
#pragma unroll
        for (int ai = 0; ai < 2; ++ai)
#pragma unroll
            for (int m = 0; m < 4; ++m) { const int rl = ai * HALF + wr * 64 + m * 16 + fr; const size_t off = (size_t)(u.pm * BM + rl) * ldc + col0; float q = 0.f;
#pragma unroll
                for (int bj = 0; bj < 2; ++bj) { const u32x4 hb = *(const u32x4*)(xb + off + bj * HALF);
                    const f32x4 b0 = (f32x4){__uint_as_float(hb.x << 16), __uint_as_float(hb.x & 0xffff0000u), __uint_as_float(hb.y << 16), __uint_as_float(hb.y & 0xffff0000u)};
                    const f32x4 b1 = (f32x4){__uint_as_float(hb.z << 16), __uint_as_float(hb.z & 0xffff0000u), __uint_as_float(hb.w << 16), __uint_as_float(hb.w & 0xffff0000u)};
                    const f32x4 v0 = b0 + acc[ai][bj][m][0], v1 = b1 + acc[ai][bj][m][1];
                    u32x4 w; w.x = cvt_pk_bf16(v0[0], v0[1]); w.y = cvt_pk_bf16(v0[2], v0[3]); w.z = cvt_pk_bf16(v1[0], v1[1]); w.w = cvt_pk_bf16(v1[2], v1[3]);
                    *(u32x4*)(xb + off + bj * HALF) = w;
                    q += (v0[0] * v0[0] + v0[1] * v0[1]) + (v0[2] * v0[2] + v0[3] * v0[3]) + (v1[0] * v1[0] + v1[1] * v1[1]) + (v1[2] * v1[2] + v1[3] * v1[3]); }
                q += __shfl_xor(q, 16); q += __shfl_xor(q, 32);
                if (fq == 0) P[rl * 4 + wc] = q; }
        asm volatile("s_waitcnt lgkmcnt(0)" ::: "memory"); __builtin_amdgcn_s_barrier(); asm volatile("" ::: "memory");
        const int tid = wid * 64 + lane;
        if (tid < 256) { const float s = (P[tid * 4 + 0] + P[tid * 4 + 1]) + (P[tid * 4 + 2] + P[tid * 4 + 3]); ss[(size_t)(u.pm * BM + tid) * 8 + u.pn] = s; }
        asm volatile("s_waitcnt lgkmcnt(0)" ::: "memory"); __builtin_amdgcn_s_barrier(); asm volatile("" ::: "memory");
    }
};
struct EpiResidK {
    static constexpr bool PERM = true, AFTER_DRAIN = true, KHOOK = true;
    bf16_t* xb; float* ss; int ldc; const float* rnp;
    __device__ __forceinline__ void kprep(const Unit& u, PG8_LAS unsigned char* lds, int tid) const {
        if (tid < 256) { PG8_LAS float* RT = (PG8_LAS float*)(lds + 131072 + 11264); const f32x4 a = *(const f32x4*)(rnp + (size_t)(u.pm * BM + tid) * 8), b = *(const f32x4*)(rnp + (size_t)(u.pm * BM + tid) * 8 + 4);
            RT[tid] = b[3]; RT[256 + tid] = a[0] / a[1]; RT[512 + tid] = a[1] / a[2]; RT[768 + tid] = a[2] / a[3]; RT[1024 + tid] = a[3] / b[0]; RT[1280 + tid] = b[0] / b[1]; RT[1536 + tid] = b[1] / b[2]; RT[1792 + tid] = b[2] / b[3]; } }
    __device__ __forceinline__ void khook(f32x4 (&acc)[2][2][4][2], int hb, int wr, int fr, PG8_LAS unsigned char* lds) const {
        const PG8_LAS float* RT = (const PG8_LAS float*)(lds + 131072 + 11264) + hb * 256 + wr * 64 + fr;
#pragma unroll
        for (int ai = 0; ai < 2; ++ai)
#pragma unroll
            for (int m = 0; m < 4; ++m) { const float r = RT[ai * HALF + m * 16];
#pragma unroll
                for (int bj = 0; bj < 2; ++bj)
#pragma unroll
                    for (int n = 0; n < 2; ++n) acc[ai][bj][m][n] = acc[ai][bj][m][n] * r; } }
    __device__ __forceinline__ void fused(f32x4 (&acc)[2][2][4][2], const Unit& u, int wr, int wc, int fr, int fq, PG8_LAS unsigned char* lds, int wid, int lane) const {
        khook(acc, 0, wr, fr, lds);
        PG8_LAS float* P = (PG8_LAS float*)lds;
        const int col0 = u.pn * BM + wc * 32 + 8 * fq;
#pragma unroll
        for (int ai = 0; ai < 2; ++ai)
#pragma unroll
            for (int m = 0; m < 4; ++m) { const int rl = ai * HALF + wr * 64 + m * 16 + fr; const size_t off = (size_t)(u.pm * BM + rl) * ldc + col0; float q = 0.f;
#pragma unroll
                for (int bj = 0; bj < 2; ++bj) { const u32x4 hb = *(const u32x4*)(xb + off + bj * HALF);
                    const f32x4 b0 = (f32x4){__uint_as_float(hb.x << 16), __uint_as_float(hb.x & 0xffff0000u), __uint_as_float(hb.y << 16), __uint_as_float(hb.y & 0xffff0000u)};
                    const f32x4 b1 = (f32x4){__uint_as_float(hb.z << 16), __uint_as_float(hb.z & 0xffff0000u), __uint_as_float(hb.w << 16), __uint_as_float(hb.w & 0xffff0000u)};
                    const f32x4 v0 = b0 + acc[ai][bj][m][0], v1 = b1 + acc[ai][bj][m][1];
                    u32x4 w; w.x = cvt_pk_bf16(v0[0], v0[1]); w.y = cvt_pk_bf16(v0[2], v0[3]); w.z = cvt_pk_bf16(v1[0], v1[1]); w.w = cvt_pk_bf16(v1[2], v1[3]);
                    *(u32x4*)(xb + off + bj * HALF) = w;
                    q += (v0[0] * v0[0] + v0[1] * v0[1]) + (v0[2] * v0[2] + v0[3] * v0[3]) + (v1[0] * v1[0] + v1[1] * v1[1]) + (v1[2] * v1[2] + v1[3] * v1[3]); }
                q += __shfl_xor(q, 16); q += __shfl_xor(q, 32);
                if (fq == 0) P[rl * 4 + wc] = q; }
        asm volatile("s_waitcnt lgkmcnt(0)" ::: "memory"); __builtin_amdgcn_s_barrier(); asm volatile("" ::: "memory");
        const int tid = wid * 64 + lane;
        if (tid < 256) { const float s = (P[tid * 4 + 0] + P[tid * 4 + 1]) + (P[tid * 4 + 2] + P[tid * 4 + 3]); ss[(size_t)(u.pm * BM + tid) * 8 + u.pn] = s; }
        asm volatile("s_waitcnt lgkmcnt(0)" ::: "memory"); __builtin_amdgcn_s_barrier(); asm volatile("" ::: "memory");
    }
};
struct EpiResidFinal {
    static constexpr bool PERM = true, AFTER_DRAIN = true, KHOOK = false;
    const bf16_t* xb; float* out; float* ss; const float* gain; unsigned* cnt; int ldc;
    __device__ __forceinline__ void fused(f32x4 (&acc)[2][2][4][2], const Unit& u, int wr, int wc, int fr, int fq, PG8_LAS unsigned char* lds, int wid, int lane) const {
        PG8_LAS float* P = (PG8_LAS float*)lds;
        PG8_LAS float* tbl = (PG8_LAS float*)(lds + 4096);
        const int col0 = u.pn * BM + wc * 32 + 8 * fq;
#pragma unroll
        for (int ai = 0; ai < 2; ++ai)
#pragma unroll
            for (int m = 0; m < 4; ++m) { const int rl = ai * HALF + wr * 64 + m * 16 + fr; const size_t off = (size_t)(u.pm * BM + rl) * ldc + col0; float q = 0.f;
#pragma unroll
                for (int bj = 0; bj < 2; ++bj) { const u32x4 hb = *(const u32x4*)(xb + off + bj * HALF);
                    const f32x4 b0 = (f32x4){__uint_as_float(hb.x << 16), __uint_as_float(hb.x & 0xffff0000u), __uint_as_float(hb.y << 16), __uint_as_float(hb.y & 0xffff0000u)};
                    const f32x4 b1 = (f32x4){__uint_as_float(hb.z << 16), __uint_as_float(hb.z & 0xffff0000u), __uint_as_float(hb.w << 16), __uint_as_float(hb.w & 0xffff0000u)};
                    const f32x4 v0 = b0 + acc[ai][bj][m][0], v1 = b1 + acc[ai][bj][m][1]; acc[ai][bj][m][0] = v0; acc[ai][bj][m][1] = v1;
                    q += (v0[0] * v0[0] + v0[1] * v0[1]) + (v0[2] * v0[2] + v0[3] * v0[3]) + (v1[0] * v1[0] + v1[1] * v1[1]) + (v1[2] * v1[2] + v1[3] * v1[3]); }
                q += __shfl_xor(q, 16); q += __shfl_xor(q, 32);
                if (fq == 0) P[rl * 4 + wc] = q; }
        asm volatile("s_waitcnt lgkmcnt(0)" ::: "memory"); __builtin_amdgcn_s_barrier(); asm volatile("" ::: "memory");
        const int tid = wid * 64 + lane;
        if (tid < 256) { const float sq = (P[tid * 4 + 0] + P[tid * 4 + 1]) + (P[tid * 4 + 2] + P[tid * 4 + 3]);
            __hip_atomic_store(ss + (size_t)(u.pm * BM + tid) * 8 + u.pn, sq, __ATOMIC_RELAXED, __HIP_MEMORY_SCOPE_AGENT); }
        asm volatile("s_waitcnt vmcnt(0)" ::: "memory");
        __builtin_amdgcn_s_barrier(); asm volatile("" ::: "memory");
        if (tid == 0) { unsigned* c = cnt + 16 * u.pm; __hip_atomic_fetch_add(c, 1u, __ATOMIC_RELEASE, __HIP_MEMORY_SCOPE_AGENT);
            unsigned spins = 0; while (__hip_atomic_load(c, __ATOMIC_RELAXED, __HIP_MEMORY_SCOPE_AGENT) < 8u && ++spins < (1u << 22)) __builtin_amdgcn_s_sleep(2);
            __builtin_amdgcn_fence(__ATOMIC_ACQUIRE, "agent"); }
        asm volatile("s_waitcnt vmcnt(0) lgkmcnt(0)" ::: "memory"); __builtin_amdgcn_s_barrier(); asm volatile("" ::: "memory");
        if (tid < 256) { float sq = 0.f;
#pragma unroll
            for (int t = 0; t < 8; ++t) sq += __hip_atomic_load(ss + (size_t)(u.pm * BM + tid) * 8 + t, __ATOMIC_RELAXED, __HIP_MEMORY_SCOPE_AGENT);
            tbl[tid] = 1.0f / sqrtf(sq * (1.0f / 2048.0f) + 1e-6f); }
        asm volatile("s_waitcnt lgkmcnt(0)" ::: "memory"); __builtin_amdgcn_s_barrier(); asm volatile("" ::: "memory");
        { constexpr int TROW = 1040, TSZ = 64 * TROW; const f32x4 gcol = *(const f32x4*)(gain + (size_t)u.pn * BM + 4 * lane);
#pragma unroll
          for (int p = 0; p < 4; ++p) { const int ai = p >> 1, wrp = p & 1; PG8_LAS unsigned char* T = lds + 8192 + (p & 1) * TSZ;
              if (wr == wrp) {
#pragma unroll
                  for (int bj = 0; bj < 2; ++bj)
#pragma unroll
                      for (int m = 0; m < 4; ++m)
#pragma unroll
                          for (int n = 0; n < 2; ++n) *(PG8_LAS f32x4*)(T + (m * 16 + fr) * TROW + (bj * HALF + wc * 32 + 8 * fq + 4 * n) * 4) = acc[ai][bj][m][n];
              }
              asm volatile("s_waitcnt lgkmcnt(0)" ::: "memory"); __builtin_amdgcn_s_barrier(); asm volatile("" ::: "memory");
#pragma unroll
              for (int r = 0; r < 8; ++r) { const int rl = p * 64 + 8 * wid + r; const f32x4 t = *(const PG8_LAS f32x4*)(T + (8 * wid + r) * TROW + lane * 16);
                  *(f32x4*)(out + (size_t)(u.pm * BM + rl) * ldc + (size_t)u.pn * BM + 4 * lane) = t * tbl[rl] * gcol; } } }
        asm volatile("s_waitcnt lgkmcnt(0)" ::: "memory"); __builtin_amdgcn_s_barrier(); asm volatile("" ::: "memory");
    }
};

template <class Epi, class Sched, bool ALIGN_EPI = false, bool SP2 = false>
__device__ __forceinline__ void gemm_phase(PG8_LAS unsigned char* lds, const Gemm g, const Sched& S, const Epi& E) {
    int tid_ = threadIdx.x; asm volatile("" : "+v"(tid_));
    const int tid = tid_, wid = __builtin_amdgcn_readfirstlane(tid >> 6), lane = tid & 63, wr = wid >> 2, wc = wid & 3, fr = lane & 15, fq = lane >> 4;
    const int K = g.K, nt = K / BK;
    unsigned voffA[2], voffB[2];
#pragma unroll
    for (int i = 0; i < 2; ++i) { int R, C; stage_rc(tid * 16 + i * 8192, R, C); const int Rb = Epi::PERM ? ((R & ~31) + perm32(R & 31)) : R;
        voffA[i] = (unsigned)(R * K + C) * 2u; voffB[i] = (unsigned)(Rb * K + C) * 2u; }
    const size_t kstep = (size_t)(BK * 2);
    const size_t hstep = (size_t)HALF * K * 2;
    const size_t tstep = 2 * hstep;
    const size_t tstepA = (size_t)g.arows * K * 2;
    const unsigned ldsw = (unsigned)wid * 1024u;
    const int aoff = lds_byte(wr * 64 + fr, fq * 8), boff = lds_byte(wc * 32 + fr, fq * 8);
#define PG8_SA(b, h) (((b) * 2 + (h)) * HTB)
#define PG8_SB(b, h) ((4 + (b) * 2 + (h)) * HTB)
#define PG8_STAGE(bufoff, gbase, voff) do { _Pragma("unroll") for (int _i = 0; _i < 2; ++_i) \
        __builtin_amdgcn_global_load_lds((const unsigned*)((const char*)(gbase) + (voff)[_i]), (PG8_LAS unsigned*)(lds + (bufoff) + ldsw + _i * 8192), 16, 0, 0); } while (0)
#define PG8_LDA(dst, b, h) do { _Pragma("unroll") for (int m = 0; m < 4; ++m) _Pragma("unroll") for (int k = 0; k < 2; ++k) dst[m][k] = *(const PG8_LAS bf16x8*)(lds + PG8_SA(b, h) + aoff + m * 2048 + k * 1024); } while (0)
#define PG8_LDB(dst, b, h) do { _Pragma("unroll") for (int n = 0; n < 2; ++n) _Pragma("unroll") for (int k = 0; k < 2; ++k) dst[n][k] = *(const PG8_LAS bf16x8*)(lds + PG8_SB(b, h) + boff + n * 2048 + k * 1024); } while (0)
#define PG8_MMA(ai, bj, At, Bt) do { __builtin_amdgcn_s_setprio(1); _Pragma("unroll") for (int m = 0; m < 4; ++m) _Pragma("unroll") for (int n = 0; n < 2; ++n) _Pragma("unroll") for (int k = 0; k < 2; ++k) \
        acc[ai][bj][m][n] = __builtin_amdgcn_mfma_f32_16x16x32_bf16(Bt[n][k], At[m][k], acc[ai][bj][m][n], 0, 0, 0); __builtin_amdgcn_s_setprio(0); } while (0)
#define PG8_WAIT_V(n) asm volatile("s_waitcnt vmcnt(" #n ")" ::: "memory")
#define PG8_WAIT_L(n) asm volatile("s_waitcnt lgkmcnt(" #n ")" ::: "memory")
#define PG8_BAR __builtin_amdgcn_s_barrier()
#define PG8_SCHED __builtin_amdgcn_sched_barrier(0)
    Unit cur, nxt; int ui = 0;
    if (!S.next(0, cur)) return;
    f32x4 acc[2][2][4][2];
#pragma unroll
    for (int a = 0; a < 2; ++a)
#pragma unroll
        for (int b = 0; b < 2; ++b)
#pragma unroll
            for (int m = 0; m < 4; ++m)
#pragma unroll
                for (int n = 0; n < 2; ++n) acc[a][b][m][n] = (f32x4){0.f, 0.f, 0.f, 0.f};
    bf16x8 At[4][2], B0[2][2], B1[2][2];
    const char* cA = (const char*)g.A + (size_t)cur.pm * tstepA; const char* cB = (const char*)g.Bt + (size_t)cur.pn * tstep;
    S.a_ready(cur);
    if constexpr (Epi::KHOOK) E.kprep(cur, lds, tid);
    if constexpr (SP2) {
        PG8_STAGE(PG8_SB(0, 0), cB, voffB); PG8_STAGE(PG8_SB(0, 1), cB + hstep, voffB); PG8_STAGE(PG8_SA(0, 0), cA, voffA); PG8_STAGE(PG8_SA(0, 1), cA + hstep, voffA);
        if (wr == 1) PG8_BAR;
        PG8_WAIT_V(2); PG8_BAR;
        PG8_STAGE(PG8_SB(1, 0), cB + kstep, voffB); PG8_STAGE(PG8_SA(1, 0), cA + kstep, voffA); PG8_STAGE(PG8_SB(1, 1), cB + hstep + kstep, voffB);
        PG8_WAIT_V(6); PG8_BAR;
    } else {
        PG8_STAGE(PG8_SB(0, 0), cB, voffB); PG8_STAGE(PG8_SA(0, 0), cA, voffA); PG8_STAGE(PG8_SB(0, 1), cB + hstep, voffB); PG8_STAGE(PG8_SA(0, 1), cA + hstep, voffA);
        if (wr == 1) PG8_BAR;
        PG8_WAIT_V(4); PG8_BAR;
        PG8_STAGE(PG8_SB(1, 0), cB + kstep, voffB); PG8_STAGE(PG8_SA(1, 0), cA + kstep, voffA); PG8_STAGE(PG8_SB(1, 1), cB + hstep + kstep, voffB);
        PG8_WAIT_V(6); PG8_BAR;
    }
    for (;;) {
        const bool has_next = S.next(ui + 1, nxt);
        const char* nA = has_next ? (const char*)g.A + (size_t)nxt.pm * tstepA : cA; const char* nB = has_next ? (const char*)g.Bt + (size_t)nxt.pn * tstep : cB;
        for (int t = 0; t < nt; t += 2) {
            if constexpr (Epi::KHOOK) { if ((t & 7) == 0 && t != 0) E.khook(acc, t >> 3, wr, fr, lds); }
            const bool last = (t == nt - 2);
            const char* a1 = cA + (size_t)(t + 1) * kstep;
            const char* a2 = last ? nA : cA + (size_t)(t + 2) * kstep; const char* b2 = last ? nB : cB + (size_t)(t + 2) * kstep;
            const char* a3 = a2 + kstep; const char* b3 = b2 + kstep;
            if (last && has_next) S.a_ready(nxt);
            if constexpr (SP2) {
            PG8_LDB(B0, 0, 0); PG8_LDB(B1, 0, 1); PG8_SCHED; PG8_LDA(At, 0, 0); PG8_STAGE(PG8_SA(1, 1), a1 + hstep, voffA);
            PG8_WAIT_V(8); PG8_WAIT_L(0); PG8_BAR; PG8_MMA(0, 0, At, B0); PG8_MMA(0, 1, At, B1); PG8_BAR; PG8_SCHED;
            PG8_LDA(At, 0, 1); PG8_STAGE(PG8_SB(0, 0), b2, voffB); PG8_STAGE(PG8_SB(0, 1), b2 + hstep, voffB); PG8_STAGE(PG8_SA(0, 0), a2, voffA);
            PG8_WAIT_V(8); PG8_WAIT_L(0); PG8_BAR; PG8_MMA(1, 0, At, B0); PG8_MMA(1, 1, At, B1); PG8_BAR; PG8_SCHED;
            PG8_LDB(B0, 1, 0); PG8_LDB(B1, 1, 1); PG8_SCHED; PG8_LDA(At, 1, 0); PG8_STAGE(PG8_SA(0, 1), a2 + hstep, voffA);
            PG8_WAIT_V(8); PG8_WAIT_L(0); PG8_BAR; PG8_MMA(0, 0, At, B0); PG8_MMA(0, 1, At, B1); PG8_BAR; PG8_SCHED;
            PG8_LDA(At, 1, 1); PG8_STAGE(PG8_SB(1, 0), b3, voffB); PG8_STAGE(PG8_SB(1, 1), b3 + hstep, voffB); PG8_STAGE(PG8_SA(1, 0), a3, voffA);
            PG8_WAIT_V(8); PG8_WAIT_L(0); PG8_BAR; PG8_MMA(1, 0, At, B0); PG8_MMA(1, 1, At, B1); PG8_BAR; PG8_SCHED;
            } else {
            PG8_LDB(B0, 0, 0); PG8_SCHED; PG8_LDA(At, 0, 0); PG8_STAGE(PG8_SA(1, 1), a1 + hstep, voffA);
            PG8_WAIT_L(8); PG8_BAR; PG8_WAIT_L(0); PG8_MMA(0, 0, At, B0); PG8_BAR; PG8_SCHED;
            PG8_LDB(B1, 0, 1); PG8_STAGE(PG8_SB(0, 0), b2, voffB);
            PG8_BAR; PG8_WAIT_L(0); PG8_MMA(0, 1, At, B1); PG8_BAR;
            PG8_LDA(At, 0, 1); PG8_STAGE(PG8_SA(0, 0), a2, voffA);
            PG8_BAR; PG8_WAIT_L(0); PG8_MMA(1, 0, At, B0); PG8_BAR; PG8_SCHED;
            PG8_STAGE(PG8_SB(0, 1), b2 + hstep, voffB);
            PG8_WAIT_V(6); PG8_BAR; PG8_MMA(1, 1, At, B1); PG8_BAR;
            PG8_LDB(B0, 1, 0); PG8_SCHED; PG8_LDA(At, 1, 0); PG8_STAGE(PG8_SA(0, 1), a2 + hstep, voffA);
            PG8_WAIT_L(8); PG8_BAR; PG8_WAIT_L(0); PG8_MMA(0, 0, At, B0); PG8_BAR; PG8_SCHED;
            PG8_LDB(B1, 1, 1); PG8_STAGE(PG8_SB(1, 0), b3, voffB);
            PG8_BAR; PG8_WAIT_L(0); PG8_MMA(0, 1, At, B1); PG8_BAR;
            PG8_LDA(At, 1, 1); PG8_STAGE(PG8_SA(1, 0), a3, voffA);
            PG8_BAR; PG8_WAIT_L(0); PG8_MMA(1, 0, At, B0); PG8_BAR; PG8_SCHED;
            PG8_STAGE(PG8_SB(1, 1), b3 + hstep, voffB);
            PG8_WAIT_V(6); PG8_BAR; PG8_MMA(1, 1, At, B1); PG8_BAR;
            }
        }
        if constexpr (ALIGN_EPI) { if (wr == 0) PG8_BAR; }
        if constexpr (!Epi::AFTER_DRAIN) { E(acc, cur, wr, wc, fr, fq, lds, wid, lane); S.done(cur); }
        if (!has_next) break;
#pragma unroll
        for (int a = 0; a < 2; ++a)
#pragma unroll
            for (int b = 0; b < 2; ++b)
#pragma unroll
                for (int m = 0; m < 4; ++m)
#pragma unroll
                    for (int n = 0; n < 2; ++n) acc[a][b][m][n] = (f32x4){0.f, 0.f, 0.f, 0.f};
        cur = nxt; cA = nA; cB = nB; ++ui;
        if constexpr (ALIGN_EPI) { if (wr == 1) PG8_BAR; }
    }
    PG8_WAIT_V(0);
    if constexpr (!ALIGN_EPI) { if (wr == 0) PG8_BAR; }
    PG8_BAR;
    if constexpr (Epi::AFTER_DRAIN) { E.fused(acc, cur, wr, wc, fr, fq, lds, wid, lane); S.done(cur); }
#undef PG8_SA
#undef PG8_SB
#undef PG8_STAGE
#undef PG8_LDA
#undef PG8_LDB
#undef PG8_MMA
#undef PG8_WAIT_V
#undef PG8_WAIT_L
#undef PG8_BAR
#undef PG8_SCHED
}
}
constexpr int SEQ = 8192, DM = 2048, FF = 5504, FF2 = 11008;
constexpr int RIN = 12288;
constexpr int AIN = 2560;
constexpr float EPS = 1e-6f;
constexpr size_t MiB = 1u << 20;
constexpr size_t WS_SS = 0;
constexpr size_t WS_CTL = 512 * 1024, CTL_BYTES = 16384;
constexpr int LDS_CTL_OFF = 155648 - 64;
constexpr size_t WS_W_RIN = 1 * MiB;
constexpr size_t WS_W_ROUT = 49 * MiB;
constexpr size_t WS_W_QKV = 65 * MiB;
constexpr size_t WS_W_AOUT = 75 * MiB;
constexpr size_t WS_W_UP = 83 * MiB;
constexpr size_t WS_W_DN = 169 * MiB;
constexpr size_t WS_XB = 212 * MiB + 8192;
constexpr size_t WS_ACT = 245 * MiB;
constexpr size_t WS_PROJ = WS_ACT  , WS_KVT = WS_ACT + 96 * MiB  , WS_ST = WS_ACT + 194 * MiB, WS_Y = WS_ACT + 322 * MiB;
constexpr int KVT_LD = SEQ + 64;
constexpr size_t WS_U = WS_ACT, WS_HM = WS_ACT + 172 * MiB;
constexpr size_t WS_QKV = WS_ACT, WS_AO = WS_ACT + 40 * MiB;
constexpr size_t WS_END = WS_ACT + 386 * MiB;
constexpr int LDS_BYTES = 155648;

#define LAS __attribute__((address_space(3)))
typedef unsigned short bf16;
typedef unsigned v4u __attribute__((ext_vector_type(4)));
typedef unsigned v2u __attribute__((ext_vector_type(2)));
typedef float f32x4 __attribute__((ext_vector_type(4)));
typedef short bf16x8 __attribute__((ext_vector_type(8)));
typedef short s16x4 __attribute__((ext_vector_type(4)));
#define LDS_WAIT() asm volatile("s_waitcnt lgkmcnt(0)" ::: "memory")
#define LBAR() do { asm volatile("s_waitcnt lgkmcnt(0)" ::: "memory"); __builtin_amdgcn_s_barrier(); asm volatile("" ::: "memory"); } while (0)
__device__ __forceinline__ unsigned pk2(float lo, float hi) { return pg8::cvt_pk_bf16(lo, hi); }
__device__ __forceinline__ float bf_lo(unsigned w) { return __uint_as_float(w << 16); }
__device__ __forceinline__ float bf_hi(unsigned w) { return __uint_as_float(w & 0xffff0000u); }
__device__ __forceinline__ s16x4 tr_read(LAS const unsigned char* p) { return __builtin_bit_cast(s16x4, __builtin_amdgcn_ds_read_tr16_b64_v4i16((LAS s16x4*)p)); }
__device__ __forceinline__ bf16x8 cat8(s16x4 a, s16x4 b) { return (bf16x8){a[0], a[1], a[2], a[3], b[0], b[1], b[2], b[3]}; }
__device__ __forceinline__ bf16x8 pack8(f32x4 a, f32x4 b) { v4u w; w.x = pk2(a[0], a[1]); w.y = pk2(a[2], a[3]); w.z = pk2(b[0], b[1]); w.w = pk2(b[2], b[3]); return __builtin_bit_cast(bf16x8, w); }
#define MFMA16(a, b, c) __builtin_amdgcn_mfma_f32_16x16x32_bf16((a), (b), (c), 0, 0, 0)
__device__ __forceinline__ float wave_sum(float v) {
#pragma unroll
    for (int o = 1; o < 64; o <<= 1) v += __shfl_xor(v, o);
    return v;
}

#define XB_TMO      128
#define XB_XCNT(j)  (256  + 64 * (j))
#define XB_XSUB(j)  (1280 + 64 * (j))
#define XB_XGEN(j)  (2304 + 64 * (j))
#define XB_TOP      3328
#define XB_TOPGEN   3392
#define XCD_BAR_WORDS 3456
#define XB_SPIN_CAP (1u << 18)

__device__ __forceinline__ unsigned xb_ld(unsigned* p)              { return __hip_atomic_load(p, __ATOMIC_RELAXED, __HIP_MEMORY_SCOPE_AGENT); }
__device__ __forceinline__ unsigned xb_add(unsigned* p, unsigned v) { return __hip_atomic_fetch_add(p, v, __ATOMIC_RELAXED, __HIP_MEMORY_SCOPE_AGENT); }
__device__ __forceinline__ unsigned xb_xcc_id() { return (unsigned)__builtin_amdgcn_s_getreg((3 << 11) | 20) & 0xFu; }
#define XB_SPIN(cond, bar) do { unsigned _sp = 0; while (cond) { __builtin_amdgcn_s_sleep(1); \
    if ((++_sp & 255u) == 0u) { if (xb_ld(&(bar)[XB_TMO])) break; if (_sp > XB_SPIN_CAP) { atomicAdd(&(bar)[XB_TMO], 1u); break; } } } } while (0)

struct XcdBarrier {
    unsigned* bar; unsigned x;
    volatile LAS unsigned* st;
};

__device__ __forceinline__ XcdBarrier xcd_barrier_post(unsigned* bar, volatile LAS unsigned* st) {
    XcdBarrier b; b.bar = bar; b.x = xb_xcc_id(); b.st = st;
    if (threadIdx.x == 0) (void)xb_add(&bar[XB_XCNT(b.x)], 1u);
    return b;
}
__device__ __forceinline__ void xcd_barrier_complete(unsigned* bar, unsigned x, unsigned& nloc, unsigned& nx) {
    const unsigned G = gridDim.x * gridDim.y * gridDim.z;
    unsigned sum, cnt, mine, sp = 0u;
    for (;;) {
        sum = 0u; cnt = 0u; mine = 0u;
#pragma unroll
        for (unsigned j = 0; j < 16; ++j) { const unsigned c = xb_ld(&bar[XB_XCNT(j)]); sum += c; cnt += (c > 0u) ? 1u : 0u; mine = (j == x) ? c : mine; }
        if (sum == G) break;
        __builtin_amdgcn_s_sleep(1);
        if ((++sp & 255u) == 0u) { if (xb_ld(&bar[XB_TMO])) break; if (sp > XB_SPIN_CAP) { atomicAdd(&bar[XB_TMO], 1u); break; } }
    }
    nloc = mine > 0u ? mine : 1u; nx = cnt > 0u ? cnt : 1u;
}

__device__ __forceinline__ void xcd_barrier(const XcdBarrier& b) {
    asm volatile("s_waitcnt vmcnt(0)" ::: "memory");
    __syncthreads();
    if (threadIdx.x == 0) {
        unsigned* bar = b.bar;
        __builtin_amdgcn_s_waitcnt(0);
        unsigned nloc = b.st[0], nx = b.st[1];
        if (nloc == 0u) { xcd_barrier_complete(bar, b.x, nloc, nx); b.st[0] = nloc; b.st[1] = nx; }
        const unsigned old = xb_add(&bar[XB_XSUB(b.x)], 1u);
        const unsigned gen = old / nloc;
        if (old + 1u == (gen + 1u) * nloc) {
            __builtin_amdgcn_fence(__ATOMIC_RELEASE, "agent");
            asm volatile("s_waitcnt vmcnt(0)" ::: "memory");
            const unsigned og = xb_add(&bar[XB_TOP], 1u);
            const unsigned tg = og / nx;
            if (og + 1u == (tg + 1u) * nx) xb_add(&bar[XB_TOPGEN], 1u);
            else XB_SPIN(xb_ld(&bar[XB_TOPGEN]) == tg, bar);
            __builtin_amdgcn_fence(__ATOMIC_ACQUIRE, "agent");
            xb_add(&bar[XB_XGEN(b.x)], 1u);
            asm volatile("s_waitcnt vmcnt(0)" ::: "memory");
        } else {
            XB_SPIN(xb_ld(&bar[XB_XGEN(b.x)]) == gen, bar);
            __builtin_amdgcn_fence(__ATOMIC_ACQUIRE, "agent");
            asm volatile("s_waitcnt vmcnt(0)" ::: "memory");
        }
    }
    __syncthreads();
}

__device__ __forceinline__ void transpose_item(const float* W, int K, int N, bf16* WT, const float* gain, int remap, LAS float* scr, int item, int lane) {
    const int nblk = N / 64, kb = item / nblk, nb = item % nblk, k0 = 64 * kb, n0 = 64 * nb;
    f32x4 v[16];
#pragma unroll
    for (int i = 0; i < 16; ++i) v[i] = __builtin_nontemporal_load((const f32x4*)(W + (size_t)(k0 + 4 * i + (lane >> 4)) * N + n0 + 4 * (lane & 15)));
#pragma unroll
    for (int i = 0; i < 16; ++i) { const int kk = 4 * i + (lane >> 4); const float gv = gain ? gain[k0 + kk] : 1.0f; *(LAS f32x4*)(scr + kk * 68 + 4 * (lane & 15)) = v[i] * gv; }
    LDS_WAIT(); asm volatile("" ::: "memory");
    int r0 = n0; if (remap == 1) { if (n0 >= 8192) r0 = n0 - 6144; else if (n0 >= 2048) r0 = n0 + 4096; }
    else if (remap == 2) { const int jj = (n0 < FF) ? n0 : n0 - FF; r0 = (jj >> 7) * 256 + (jj & 127) + ((n0 < FF) ? 0 : 128); }
    const int c = lane & 7;
#pragma unroll
    for (int j = 0; j < 8; ++j) { const int n = (lane >> 3) + 8 * j; const LAS float* s = scr + (8 * c) * 68 + n;
        v4u o; o.x = pk2(s[0 * 68], s[1 * 68]); o.y = pk2(s[2 * 68], s[3 * 68]); o.z = pk2(s[4 * 68], s[5 * 68]); o.w = pk2(s[6 * 68], s[7 * 68]);
        *(v4u*)(WT + (size_t)(r0 + n) * K + k0 + 8 * c) = o; }
    LDS_WAIT(); asm volatile("" ::: "memory");
}
struct Args { const float* in[14]; float* out; unsigned char* ws; int ph_lo, ph_hi; };

__device__ __forceinline__ void convert_set(const Args& a, LAS unsigned char* lds, int set, int wave, int lane, int worker, int nworkers) {
    LAS float* scr = (LAS float*)(lds + wave * 17408);
    unsigned char* ws = a.ws;
    constexpr int I_RIN = 32 * (RIN / 64), I_ROUT = 64 * (DM / 64), I_QKV = 32 * (AIN / 64), I_AOUT = 32 * (DM / 64), I_UP = 32 * (FF2 / 64), I_DN = (FF / 64) * (DM / 64);
    const int n = (set == 0) ? (I_RIN + I_ROUT + I_QKV + I_UP) : (set == 1) ? (I_AOUT + I_DN) : (set == 2) ? I_UP : I_DN;
    for (int it = worker; it < n; it += nworkers) {
        int r = it; const float* W; int K, N, remap = 0; bf16* WT; const float* gain = nullptr;
        if (set == 0) {
            if (r < I_RIN) { W = a.in[2]; K = DM; N = RIN; WT = (bf16*)(ws + WS_W_RIN); gain = a.in[1]; remap = 1; }
            else if ((r -= I_RIN) < I_ROUT) { W = a.in[3]; K = 4096; N = DM; WT = (bf16*)(ws + WS_W_ROUT); }
            else if ((r -= I_ROUT) < I_QKV) { W = a.in[4]; K = DM; N = AIN; WT = (bf16*)(ws + WS_W_QKV); gain = a.in[1] + DM; }
            else { r -= I_QKV; W = a.in[9]; K = DM; N = FF2; WT = (bf16*)(ws + WS_W_UP); gain = a.in[8]; remap = 2; }
        } else if (set == 1) {
            if (r < I_AOUT) { W = a.in[7]; K = DM; N = DM; WT = (bf16*)(ws + WS_W_AOUT); }
            else { r -= I_AOUT; W = a.in[12]; K = FF; N = DM; WT = (bf16*)(ws + WS_W_DN); }
        } else if (set == 2) { W = a.in[9] + (size_t)DM * FF2; K = DM; N = FF2; WT = (bf16*)(ws + WS_W_UP) + (size_t)FF2 * DM; gain = a.in[8] + DM; remap = 2; }
        else { W = a.in[12] + (size_t)FF * DM; K = FF; N = DM; WT = (bf16*)(ws + WS_W_DN) + (size_t)DM * FF; }
        transpose_item(W, K, N, WT, gain, remap, scr, r, lane);
    }
}
__device__ __forceinline__ void prologue(const Args& a, LAS unsigned char* lds, int G, int bid) {
    int tid_ = threadIdx.x; asm volatile("" : "+v"(tid_));
    const int tid = tid_, lane = tid & 63, wave = __builtin_amdgcn_readfirstlane(tid >> 6);
    LAS float* scr = (LAS float*)(lds + wave * 17408);
    const int gw = bid * 8 + wave, NGW = G * 8;
    unsigned char* ws = a.ws;
    convert_set(a, lds, 0, wave, lane, gw, NGW);
    { v4u* hz0 = (v4u*)(ws + WS_XB - 8192); v4u* hz1 = (v4u*)(ws + WS_XB + (size_t)SEQ * DM * 2); const int gt = bid * 512 + tid;
      for (int i = gt; i < 512; i += G * 512) hz0[i] = (v4u){0u, 0u, 0u, 0u};
      for (int i = gt; i < 190 * 256; i += G * 512) hz1[i] = (v4u){0u, 0u, 0u, 0u}; }
    const float* x = a.in[0]; bf16* XB = (bf16*)(ws + WS_XB); float* ss = (float*)(ws + WS_SS);
    for (int m = gw; m < SEQ; m += NGW) {
        const f32x4* xr = (const f32x4*)(x + (size_t)m * DM) + lane; f32x4 v[8]; float s = 0.f;
#pragma unroll
        for (int j = 0; j < 8; ++j) { v[j] = xr[64 * j]; s += (v[j][0] * v[j][0] + v[j][1] * v[j][1]) + (v[j][2] * v[j][2] + v[j][3] * v[j][3]); }
        s = wave_sum(s);
        v2u* o8 = (v2u*)(XB + (size_t)m * DM) + lane;
#pragma unroll
        for (int j = 0; j < 8; ++j) { v2u w; w.x = pk2(v[j][0], v[j][1]); w.y = pk2(v[j][2], v[j][3]); o8[64 * j] = w; }
        if (lane < 8) ss[(size_t)m * 8 + lane] = (lane == 0) ? s : 0.f;
    }
}

__device__ __forceinline__ void ret_scan_phase(LAS unsigned char* lds, const bf16* KVT, bf16* ST, int G, int bid) {
    int tid_ = threadIdx.x; asm volatile("" : "+v"(tid_));
    const int tid = tid_, lane = tid & 63, w = __builtin_amdgcn_readfirstlane(tid >> 6), g = lane >> 4, li = lane & 15;
    for (int u = bid; u < 256; u += G) {
        const int h = u & 7, dq = (u >> 6) & 3, es = (u >> 3) & 7;
        const float gam = 1.0f - exp2f(-5.0f - (float)h); const float dec = exp2f(128.0f * log2f(gam));
        const bf16* src[4]; unsigned dst[4];
#pragma unroll
        for (int i = 0; i < 4; ++i) { const int bI = 4 * w + i, row = 4 * (bI & 15) + (lane >> 4), piece = (lane & 15) ^ (row & 15);
            const size_t grow = (bI < 16) ? (size_t)(h * 256 + dq * 64 + row) : (size_t)(2048 + h * 512 + es * 64 + row);
            src[i] = KVT + grow * KVT_LD + piece * 8; dst[i] = (unsigned)((bI < 16 ? 0 : 16384) + (bI & 15) * 1024); }
#define RS_DMA(c, slot) do { const int cc_ = ((c) < 63) ? (c) : 63; _Pragma("unroll") for (int i = 0; i < 4; ++i) \
            __builtin_amdgcn_global_load_lds((const unsigned*)(src[i] + cc_ * 128), (LAS unsigned*)(lds + (slot) * 32768 + dst[i]), 16, 0, 0); } while (0)
        const int e0l = 16 * (w & 3), d0l = 32 * (w >> 2);
        const int offA0 = (d0l + li) * 256, offA1 = (d0l + 16 + li) * 256, offB = 16384 + (e0l + li) * 256;
        const int stw = (e0l + li) * 144 + (d0l + 4 * g) * 2;
        const int str_ = (tid >> 3) * 144 + (tid & 7) * 16;
        bf16* stp = ST + ((size_t)(h * 64 * 512 + es * 64 + (tid >> 3))) * 256 + dq * 64 + (tid & 7) * 8;
        f32x4 acc[2]; acc[0] = (f32x4){0.f, 0.f, 0.f, 0.f}; acc[1] = acc[0];
        RS_DMA(0, 0); RS_DMA(1, 1); RS_DMA(2, 2);
#define RS_STEP(c, NW) do { asm volatile("s_waitcnt vmcnt(" #NW ")\n\ts_barrier" ::: "memory"); \
            if ((c) >= 1) { const v4u x_ = *(const LAS v4u*)(lds + 131072 + (((c) - 1) & 1) * 9216 + str_); *(v4u*)(stp + (size_t)(c) * (512 * 256)) = x_; } \
            const LAS unsigned char* sl = lds + ((c) & 3) * 32768; \
            bf16x8 fb_[4], fa0_[4], fa1_[4]; \
            _Pragma("unroll") for (int ks = 0; ks < 4; ++ks) { const int pos = ((4 * ks + g) ^ li) * 16; \
                fb_[ks] = *(const LAS bf16x8*)(sl + offB + pos); fa0_[ks] = *(const LAS bf16x8*)(sl + offA0 + pos); fa1_[ks] = *(const LAS bf16x8*)(sl + offA1 + pos); } \
            __builtin_amdgcn_sched_barrier(0); \
            _Pragma("unroll") for (int ks = 0; ks < 4; ++ks) { acc[0] = MFMA16(fa0_[ks], fb_[ks], acc[0]); acc[1] = MFMA16(fa1_[ks], fb_[ks], acc[1]); } \
            __builtin_amdgcn_sched_barrier(0); \
            _Pragma("unroll") for (int i = 0; i < 2; ++i) { acc[i] = acc[i] * dec; v2u o; o.x = pk2(acc[i][0], acc[i][1]); o.y = pk2(acc[i][2], acc[i][3]); \
                *(LAS v2u*)(lds + 131072 + ((c) & 1) * 9216 + stw + 32 * i) = o; } \
            asm volatile("s_waitcnt lgkmcnt(0)" ::: "memory"); \
            RS_DMA((c) + 3, ((c) + 3) & 3); } while (0)
        RS_STEP(0, 8); RS_STEP(1, 8); RS_STEP(2, 9);
#pragma unroll 1
        for (int c = 3; c < 63; ++c) RS_STEP(c, 10);
        asm volatile("s_waitcnt vmcnt(0)\n\ts_barrier" ::: "memory");
        { const v4u x_ = *(const LAS v4u*)(lds + 131072 + (62 & 1) * 9216 + str_); *(v4u*)(stp + (size_t)63 * (512 * 256)) = x_; }
        asm volatile("s_waitcnt lgkmcnt(0)\n\ts_barrier" ::: "memory");
#undef RS_DMA
#undef RS_STEP
    }
}

__device__ __forceinline__ void ret_out_phase(LAS unsigned char* lds, const bf16* PROJ, const bf16* KVT, const bf16* ST, bf16* Y, float* RN, int G, int bid) {
    int tid_ = threadIdx.x; asm volatile("" : "+v"(tid_));
    constexpr int KROW = 272  , VROW = 272, SROW = 528;
    constexpr int BUF0 = 0, VTB = 64 * VROW  , BUFSZ = VTB + 64 * SROW  , BUF1 = BUFSZ, KS = BUFSZ;
    for (int u = bid; u < 512; u += G) {
        asm volatile("" : "+v"(tid_));
        const int tid = tid_, lane = tid & 63, w = __builtin_amdgcn_readfirstlane(tid >> 6), g = lane >> 4, li = lane & 15;
        const int h = u >> 6, c = u & 63, t0 = c * 128, n0 = 16 * w;
        const bool cross = (c > 0);
        bf16x8 qf[8];
#pragma unroll
        for (int ks = 0; ks < 8; ++ks) qf[ks] = *(const bf16x8*)(PROJ + (size_t)(t0 + n0 + li) * 6144 + h * 256 + 32 * ks + 8 * g);
        {
            v4u rk[8];
#pragma unroll
            for (int i = 0; i < 8; ++i) { const int q = tid + 512 * i; rk[i] = *(const v4u*)(KVT + (size_t)(h * 256 + (q >> 4)) * KVT_LD + t0 + (q & 15) * 8); }
#pragma unroll
            for (int i = 0; i < 8; ++i) { const int q = tid + 512 * i; *(LAS v4u*)(lds + KS + (q >> 4) * KROW + (q & 15) * 16) = rk[i]; }
        }
        v4u rvA[2], rsA[4];
#define RO_LOAD(rv, rs, ec) do { _Pragma("unroll") for (int i = 0; i < 2; ++i) { const int q = tid + 512 * i; \
            rv[i] = *(const v4u*)(KVT + (size_t)(2048 + h * 512 + (ec) * 64 + (q >> 4)) * KVT_LD + t0 + (q & 15) * 8); } \
            if (cross) { _Pragma("unroll") for (int i = 0; i < 4; ++i) { const int q = tid + 512 * i; \
            rs[i] = *(const v4u*)(ST + ((size_t)((h * 64 + c) * 512 + (ec) * 64 + (q >> 5))) * 256 + (q & 31) * 8); } } } while (0)
#define RO_WRITE(rv, rs, buf) do { _Pragma("unroll") for (int i = 0; i < 2; ++i) { const int q = tid + 512 * i; *(LAS v4u*)(lds + (buf) + (q >> 4) * VROW + (q & 15) * 16) = rv[i]; } \
            if (cross) { _Pragma("unroll") for (int i = 0; i < 4; ++i) { const int q = tid + 512 * i; *(LAS v4u*)(lds + (buf) + VTB + (q >> 5) * SROW + (q & 31) * 16) = rs[i]; } } } while (0)
        RO_LOAD(rvA, rsA, 0); RO_WRITE(rvA, rsA, BUF0);
        LBAR();
        bf16x8 pf[4];
        {
            f32x4 sacc[8];
#pragma unroll
            for (int mt = 0; mt < 8; ++mt) { sacc[mt] = (f32x4){0.f, 0.f, 0.f, 0.f};
                if (mt <= w) {
                    s16x4 ta_[8], tb_[8];
#pragma unroll
                    for (int ks = 0; ks < 8; ++ks) { const LAS unsigned char* p = lds + KS + (32 * ks + 8 * g + (li >> 2)) * KROW + (16 * mt + 4 * (li & 3)) * 2; ta_[ks] = tr_read(p); tb_[ks] = tr_read(p + 4 * KROW); }
                    __builtin_amdgcn_sched_barrier(0);
#pragma unroll
                    for (int ks = 0; ks < 8; ++ks) sacc[mt] = MFMA16(cat8(ta_[ks], tb_[ks]), qf[ks], sacc[mt]);
                    __builtin_amdgcn_sched_barrier(0);
#pragma unroll
                    for (int r = 0; r < 4; ++r) if (16 * mt + 4 * g + r > n0 + li) sacc[mt][r] = 0.f;
                } }
#pragma unroll
            for (int i = 0; i < 4; ++i) pf[i] = pack8(sacc[2 * i], sacc[2 * i + 1]);
        }
        LBAR();
        RO_LOAD(rvA, rsA, 1);
        const float lgam = log2f(1.0f - exp2f(-5.0f - (float)h)); const float rsc = exp2f(lgam * (float)(n0 + li + 1));
        float q2 = 0.f;
        LAS unsigned char* stg = lds + 120832 + w * 2304;
        const bf16* grow_ = PROJ + (size_t)(t0 + n0 + (lane >> 3)) * 6144 + 2048 + h * 512 + (lane & 7) * 8;
#define RO_BODY(ec, cur) do { \
            v4u gt_[2]; \
            _Pragma("unroll") for (int et = 0; et < 4; ++et) { f32x4 acc = (f32x4){0.f, 0.f, 0.f, 0.f}; \
                if (et == 2) { _Pragma("unroll") for (int i = 0; i < 2; ++i) gt_[i] = *(const v4u*)(grow_ + (size_t)(8 * i) * 6144 + (ec) * 64); }     \
                  \
                s16x4 lo_[4], hi_[4]; _Pragma("unroll") for (int i = 0; i < 4; ++i) { const LAS unsigned char* p = lds + (cur) + (16 * et + li) * VROW + (32 * i + 4 * g) * 2; lo_[i] = *(const LAS s16x4*)p; hi_[i] = *(const LAS s16x4*)(p + 32); } \
                if (cross) { bf16x8 sa_[4], sb_[4]; const LAS unsigned char* ps = lds + (cur) + VTB + (16 * et + li) * SROW + 16 * g; \
                    _Pragma("unroll") for (int ks = 0; ks < 4; ++ks) sa_[ks] = *(const LAS bf16x8*)(ps + 64 * ks); \
                    __builtin_amdgcn_sched_barrier(0); \
                    _Pragma("unroll") for (int i = 0; i < 4; ++i) acc = MFMA16(cat8(lo_[i], hi_[i]), pf[i], acc); \
                    _Pragma("unroll") for (int ks = 0; ks < 4; ++ks) sb_[ks] = *(const LAS bf16x8*)(ps + 256 + 64 * ks); \
                    __builtin_amdgcn_sched_barrier(0); \
                    _Pragma("unroll") for (int ks = 0; ks < 4; ++ks) acc = MFMA16(sa_[ks], qf[ks], acc); \
                    __builtin_amdgcn_sched_barrier(0); \
                    _Pragma("unroll") for (int ks = 0; ks < 4; ++ks) acc = MFMA16(sb_[ks], qf[4 + ks], acc); } \
                else { __builtin_amdgcn_sched_barrier(0); _Pragma("unroll") for (int i = 0; i < 4; ++i) acc = MFMA16(cat8(lo_[i], hi_[i]), pf[i], acc); } \
                __builtin_amdgcn_sched_barrier(0); \
                acc = acc * rsc; q2 += (acc[0] * acc[0] + acc[1] * acc[1]) + (acc[2] * acc[2] + acc[3] * acc[3]); \
                v2u o; o.x = pk2(acc[0], acc[1]); o.y = pk2(acc[2], acc[3]); *(LAS v2u*)(stg + li * 144 + et * 32 + g * 8) = o; }   \
            _Pragma("unroll") for (int i = 0; i < 2; ++i) { const int row = (lane >> 3) + 8 * i; const v4u x = *(const LAS v4u*)(stg + row * 144 + (lane & 7) * 16); v4u yo_; \
                _Pragma("unroll") for (int k = 0; k < 4; ++k) { const float g0 = bf_lo(gt_[i][k]), g1 = bf_hi(gt_[i][k]); \
                    yo_[k] = pk2(g0 * __builtin_amdgcn_rcpf(1.0f + __expf(-g0)) * bf_lo(x[k]), g1 * __builtin_amdgcn_rcpf(1.0f + __expf(-g1)) * bf_hi(x[k])); } \
                *(v4u*)(Y + (size_t)(t0 + n0 + row) * 4096 + h * 512 + (ec) * 64 + (lane & 7) * 8) = yo_; }   \
        } while (0)
#pragma unroll 1
        for (int ec = 0; ec < 8; ec += 2) {
            RO_BODY(ec, BUF0);
            RO_WRITE(rvA, rsA, BUF1); LBAR();
            if (ec + 2 < 8) RO_LOAD(rvA, rsA, ec + 2);
            RO_BODY(ec + 1, BUF1);
            if (ec + 2 < 8) { RO_WRITE(rvA, rsA, BUF0); LBAR(); RO_LOAD(rvA, rsA, ec + 3); }
        }
#undef RO_BODY
#undef RO_LOAD
#undef RO_WRITE
        q2 += __shfl_xor(q2, 16); q2 += __shfl_xor(q2, 32);
        if (g == 0) RN[(size_t)(t0 + n0 + li) * 8 + h] = 1.0f / sqrtf(q2 * (1.0f / 512.0f) + EPS);
        LBAR();
    }
}

__device__ __forceinline__ void attn_phase(LAS unsigned char* lds, const bf16* QKV, const float* sinks, bf16* AO, int G, int bid) {
    int tid_ = threadIdx.x; asm volatile("" : "+v"(tid_));
    const int tid = tid_, lane = tid & 63, w = __builtin_amdgcn_readfirstlane(tid >> 6), g = lane >> 4, li = lane & 15;
    constexpr int ROW = 144, KS = 0, VS = 272 * ROW;
    for (int u = bid; u < 256; u += G) {
        const int hk = u & 3, nb = u >> 2;
        {
            v4u rk[4], rv[4];
#pragma unroll
            for (int i = 0; i < 4; ++i) { const int q = tid + 512 * i; const int t = nb * 128 - 128 + (q >> 3);
                if (t >= 0) { rk[i] = *(const v4u*)(QKV + (size_t)t * AIN + 2048 + hk * 64 + (q & 7) * 8); rv[i] = *(const v4u*)(QKV + (size_t)t * AIN + 2304 + hk * 64 + (q & 7) * 8); }
                else { rk[i] = (v4u){0u, 0u, 0u, 0u}; rv[i] = rk[i]; } }
#pragma unroll
            for (int i = 0; i < 4; ++i) { const int q = tid + 512 * i; *(LAS v4u*)(lds + KS + (q >> 3) * ROW + (q & 7) * 16) = rk[i]; *(LAS v4u*)(lds + VS + (q >> 3) * ROW + (q & 7) * 16) = rv[i]; }
            if (tid < 144) { *(LAS v4u*)(lds + KS + 256 * ROW + tid * 16) = (v4u){0u, 0u, 0u, 0u}; *(LAS v4u*)(lds + VS + 256 * ROW + tid * 16) = (v4u){0u, 0u, 0u, 0u}; }
        }
        LBAR();
        const int qfr = 128 + 16 * w + li;
        const bf16* qrow = QKV + (size_t)(nb * 128 + 16 * w + li) * AIN + hk * 8 * 64 + 8 * g;
        bf16x8 qn0 = *(const bf16x8*)(qrow), qn1 = *(const bf16x8*)(qrow + 32);
        float sinkn = sinks[hk * 8];
#pragma unroll 1
        for (int hg = 0; hg < 8; ++hg) {
            const int hq = hk * 8 + hg;
            const float slope = exp2f(-0.25f * (float)(hq + 1)); const float sink = sinkn;
            const bf16x8 q0 = qn0, q1 = qn1;
            { const int hn = (hg < 7) ? hg + 1 : 7; qn0 = *(const bf16x8*)(qrow + hn * 64); qn1 = *(const bf16x8*)(qrow + hn * 64 + 32); sinkn = sinks[hk * 8 + hn]; }
            f32x4 sc[10]; float mx = sink;
#pragma unroll
            for (int kh = 0; kh < 2; ++kh) {
            bf16x8 ka_[5], kb_[5];
#pragma unroll
            for (int k5 = 0; k5 < 5 - kh; ++k5) { const LAS unsigned char* p = lds + KS + (16 * (w + 5 * kh + k5) + li) * ROW + 8 * g * 2; ka_[k5] = *(const LAS bf16x8*)p; kb_[k5] = *(const LAS bf16x8*)(p + 64); }
            __builtin_amdgcn_sched_barrier(0);
#pragma unroll
            for (int k5 = 0; k5 < 5 - kh; ++k5) { const int kt = 5 * kh + k5;
                f32x4 s = (f32x4){0.f, 0.f, 0.f, 0.f};
                s = MFMA16(ka_[k5], q0, s); s = MFMA16(kb_[k5], q1, s);
#pragma unroll
                for (int r = 0; r < 4; ++r) { const int j = 4 * g + r; const int dist = 128 + li - 16 * kt - j;
                    bool valid = (kt == 0) ? (j > li) : ((kt == 8) ? (j <= li) : true);
                    if (nb == 0) valid = valid && (16 * (w + kt) + j >= 128);
                    s[r] = valid ? s[r] - slope * (float)dist : -INFINITY; mx = fmaxf(mx, s[r]); }
                sc[kt] = s; }
            __builtin_amdgcn_sched_barrier(0); }
            mx = fmaxf(mx, __shfl_xor(mx, 16)); mx = fmaxf(mx, __shfl_xor(mx, 32));
            float lsum = 0.f;
#pragma unroll
            for (int kt = 0; kt < 9; ++kt)
#pragma unroll
                for (int r = 0; r < 4; ++r) { const float p = __expf(sc[kt][r] - mx); sc[kt][r] = p; lsum += p; }
            sc[9] = (f32x4){0.f, 0.f, 0.f, 0.f};
            lsum += __shfl_xor(lsum, 16); lsum += __shfl_xor(lsum, 32);
            lsum += __expf(sink - mx);
            const float inv = 1.0f / lsum;
            f32x4 oa[4];
#pragma unroll
            for (int dt = 0; dt < 4; ++dt) oa[dt] = (f32x4){0.f, 0.f, 0.f, 0.f};
#pragma unroll
            for (int i = 0; i < 5; ++i) { const bf16x8 pfr = pack8(sc[2 * i], sc[2 * i + 1]); s16x4 va_[4], vb_[4];
#pragma unroll
                for (int dt = 0; dt < 4; ++dt) { const LAS unsigned char* p = lds + VS + (16 * (w + 2 * i) + 4 * g + (li >> 2)) * ROW + (16 * dt + 4 * (li & 3)) * 2; va_[dt] = tr_read(p); vb_[dt] = tr_read(p + 16 * ROW); }
                __builtin_amdgcn_sched_barrier(0);
#pragma unroll
                for (int dt = 0; dt < 4; ++dt) oa[dt] = MFMA16(cat8(va_[dt], vb_[dt]), pfr, oa[dt]);
                __builtin_amdgcn_sched_barrier(0); }
            LAS unsigned char* stg = lds + 2 * 272 * ROW + w * 2304;
#pragma unroll
            for (int dt = 0; dt < 4; ++dt) { v2u o; o.x = pk2(oa[dt][0] * inv, oa[dt][1] * inv); o.y = pk2(oa[dt][2] * inv, oa[dt][3] * inv); *(LAS v2u*)(stg + li * 144 + dt * 32 + g * 8) = o; }
#pragma unroll
            for (int i = 0; i < 2; ++i) { const int row = (lane >> 3) + 8 * i; const v4u x = *(const LAS v4u*)(stg + row * 144 + (lane & 7) * 16);
                *(v4u*)(AO + (size_t)(nb * 128 + 16 * w + row) * DM + hq * 64 + (lane & 7) * 8) = x; }
        }
        LBAR();
    }
}

#ifdef NO_PRO
#define PH_PRO(x) do {} while (0)
#else
#define PH_PRO(x) x
#endif
#ifdef NO_GS
#define PH_GS(x) do {} while (0)
#else
#define PH_GS(x) x
#endif
#ifdef NO_GT
#define PH_GT(x) do {} while (0)
#else
#define PH_GT(x) x
#endif
#ifdef NO_GR
#define PH_GR(x) do {} while (0)
#else
#define PH_GR(x) x
#endif
#ifdef NO_RS
#define PH_RS(x) do {} while (0)
#else
#define PH_RS(x) x
#endif
#ifdef NO_RO
#define PH_RO(x) do {} while (0)
#else
#define PH_RO(x) x
#endif
#ifdef NO_CV
#define PH_CV(x) do {} while (0)
#else
#define PH_CV(x) x
#endif
#ifdef NO_AT
#define PH_AT(x) do {} while (0)
#else
#define PH_AT(x) x
#endif
#ifdef NO_FN
#define PH_FN(x) do {} while (0)
#else
#define PH_FN(x) x
#endif
enum { K_PRO = 0, K_GSCALE, K_GSCALET, K_GRESID, K_RSCAN, K_ROUT, K_CONV, K_ATTN, K_FINAL, K_GCONV, K_NONE, K_GRESIDF, K_GRESIDK };
constexpr int NSTEPS = 16;
__global__ void __launch_bounds__(512, 2) fwd_megakernel(Args a) {
    extern __shared__ __attribute__((aligned(16))) unsigned char lds_raw[];
    LAS unsigned char* lds = (LAS unsigned char*)lds_raw;
    cg::grid_group grid = cg::this_grid();
    int G = gridDim.x, bid = blockIdx.x;
    if (threadIdx.x < 16) ((LAS unsigned*)(lds + LDS_CTL_OFF))[threadIdx.x] = 0u;
    __syncthreads();
    XcdBarrier bar = xcd_barrier_post((unsigned*)(a.ws + WS_CTL), (volatile LAS unsigned*)(lds + LDS_CTL_OFF));
    for (int step = a.ph_lo; step < a.ph_hi; ++step) {
        unsigned long long lz = 0; asm volatile("" : "+s"(lz));
        unsigned char* ws = a.ws + lz; float* ss = (float*)(ws + WS_SS); bf16* XB = (bf16*)(ws + WS_XB); bf16* W_RIN = (bf16*)(ws + WS_W_RIN);
        int kind = K_PRO, layer = 0, mode = 0, ldo = 0, cset = 0; bool sync_after = true;
        pg8::Gemm gm{nullptr, nullptr, 0, 0, 0};
        bf16* obf = nullptr; const float* bias = nullptr; const float* rbase = a.out;
        switch (step) {
            case 0: kind = K_PRO; break;
            case 1: kind = K_GSCALE; gm = pg8::Gemm{XB, W_RIN, SEQ, 6144, DM}; obf = (bf16*)(ws + WS_PROJ); ldo = 6144; sync_after = false; break;
            case 2: kind = K_GSCALET; gm = pg8::Gemm{W_RIN + (size_t)6144 * DM, XB, 6144, SEQ, DM}; obf = (bf16*)(ws + WS_KVT); ldo = KVT_LD; break;
            case 3: kind = K_RSCAN; break;
            case 4: kind = K_ROUT; break;
            case 5: kind = K_GRESIDK; gm = pg8::Gemm{(bf16*)(ws + WS_Y), (bf16*)(ws + WS_W_ROUT), SEQ, DM, 4096}; break;
            case 6: kind = K_GCONV; gm = pg8::Gemm{XB - 2 * DM, (bf16*)(ws + WS_W_UP), 33 * 256, FF2, DM, 254}; layer = 0; cset = 1; break;
            case 7: kind = K_NONE; break;
            case 8: kind = K_GRESID; gm = pg8::Gemm{(bf16*)(ws + WS_HM), (bf16*)(ws + WS_W_DN), SEQ, DM, FF}; break;
            case 9: kind = K_GSCALE; gm = pg8::Gemm{XB, (bf16*)(ws + WS_W_QKV), SEQ, AIN, DM}; obf = (bf16*)(ws + WS_QKV); ldo = AIN; mode = 2; bias = a.in[5]; cset = 2; break;
            case 10: kind = K_ATTN; break;
            case 11: kind = K_GRESID; gm = pg8::Gemm{(bf16*)(ws + WS_AO), (bf16*)(ws + WS_W_AOUT), SEQ, DM, DM}; break;
            case 12: kind = K_GCONV; gm = pg8::Gemm{XB - 2 * DM, (bf16*)(ws + WS_W_UP) + (size_t)FF2 * DM, 33 * 256, FF2, DM, 254}; layer = 1; cset = 3; break;
            case 13: kind = K_NONE; break;
            case 14: kind = K_GRESIDF; gm = pg8::Gemm{(bf16*)(ws + WS_HM), (bf16*)(ws + WS_W_DN) + (size_t)DM * FF, SEQ, DM, FF}; sync_after = false; break;
            default: kind = K_NONE; sync_after = false; break;
        }
#ifndef DUP_MASK
#define DUP_MASK 0
#endif
        if (kind == K_NONE) continue;
        for (int rep = 0; rep <= ((DUP_MASK >> step) & 1); ++rep) {
        if (rep) __syncthreads();
        if (kind == K_PRO) { PH_PRO(prologue(a, lds, G, bid)); }
        else if (kind == K_GSCALE) { pg8::StaticOrder S; S.init(gm.M, gm.N, G, bid); pg8::EpiScale E{obf, ldo, ss, bias, mode};
            PH_GS((pg8::gemm_phase<pg8::EpiScale, pg8::StaticOrder, true, true>(lds, gm, S, E)));
            if (cset) { const int rem = S.nwg % G;
                if (rem == 0 || bid >= rem) { int t_ = threadIdx.x; asm volatile("" : "+v"(t_)); const int nw = (rem == 0) ? G : G - rem;
                    convert_set(a, lds, cset, __builtin_amdgcn_readfirstlane(t_ >> 6), t_ & 63, ((rem == 0) ? bid : bid - rem) * 8 + (t_ >> 6), nw * 8); } } }
        else if (kind == K_GSCALET) { pg8::StaticOrder S; S.init(gm.M, gm.N, G, bid); pg8::EpiScaleT E{obf, ldo, ss};
            PH_GT((pg8::gemm_phase<pg8::EpiScaleT, pg8::StaticOrder, true, true>(lds, gm, S, E))); }
        else if (kind == K_GCONV) { pg8::StaticOrder S; S.init(gm.M, gm.N, G, bid); pg8::EpiConv E{(bf16*)(ws + WS_HM), ss, a.in[10] + (size_t)layer * 3 * FF2, a.in[11] + (size_t)layer * FF2};
            pg8::gemm_phase<pg8::EpiConv, pg8::StaticOrder, true, true>(lds, gm, S, E);
            if (cset) { const int rem = S.nwg % G;
                if (rem == 0 || bid >= rem) { int t_ = threadIdx.x; asm volatile("" : "+v"(t_)); const int nw = (rem == 0) ? G : G - rem;
                    convert_set(a, lds, cset, __builtin_amdgcn_readfirstlane(t_ >> 6), t_ & 63, ((rem == 0) ? bid : bid - rem) * 8 + (t_ >> 6), nw * 8); } } }
        else if (kind == K_GRESIDF) { pg8::StaticOrder S; S.init(gm.M, gm.N, G, bid); pg8::EpiResidFinal E{XB, a.out, ss, a.in[13], (unsigned*)(ws + WS_CTL) + 3584, DM};
            pg8::gemm_phase<pg8::EpiResidFinal, pg8::StaticOrder, false, true>(lds, gm, S, E); }
        else if (kind == K_GRESIDK) { pg8::StaticOrder S; S.init(gm.M, gm.N, G, bid); pg8::EpiResidK E{XB, ss, DM, (const float*)(ws + WS_SS + 262144)};
            pg8::gemm_phase<pg8::EpiResidK, pg8::StaticOrder, false, true>(lds, gm, S, E); }
        else if (kind == K_GRESID) { pg8::StaticOrder S; S.init(gm.M, gm.N, G, bid); pg8::EpiResid E{XB, ss, DM};
            PH_GR((pg8::gemm_phase<pg8::EpiResid, pg8::StaticOrder, false, true>(lds, gm, S, E))); }
        else if (kind == K_RSCAN) PH_RS(ret_scan_phase(lds, (const bf16*)(ws + WS_KVT), (bf16*)(ws + WS_ST), G, bid));
        else if (kind == K_ROUT) PH_RO(ret_out_phase(lds, (const bf16*)(ws + WS_PROJ), (const bf16*)(ws + WS_KVT), (const bf16*)(ws + WS_ST), (bf16*)(ws + WS_Y), (float*)(ws + WS_SS + 262144), G, bid));
        else if (kind == K_ATTN) PH_AT(attn_phase(lds, (const bf16*)(ws + WS_QKV), a.in[6], (bf16*)(ws + WS_AO), G, bid));
        }
        if (step + 1 < a.ph_hi) { if (!sync_after) __syncthreads(); else if (a.ph_hi > NSTEPS) grid.sync(); else xcd_barrier(bar); }
    }
}

extern "C" void kernel_launch(void* const* d_in, const int* in_sizes, int n_in, void* d_out, int out_size, void* d_ws, size_t ws_size, hipStream_t stream) {
    static int grid = 0;
    if (grid == 0) {
        if (n_in != 14 || in_sizes[0] != SEQ * DM || out_size != SEQ * DM || ws_size < WS_END) { fprintf(stderr, "kernel_launch: unexpected shapes / workspace (n_in %d, ws %zu < %zu)\n", n_in, ws_size, (size_t)WS_END); grid = -1; return; }
        int dev = 0, cus = 0, per_cu = 0;
        hipGetDevice(&dev); hipDeviceGetAttribute(&cus, hipDeviceAttributeMultiprocessorCount, dev);
        if (hipFuncSetAttribute((const void*)fwd_megakernel, hipFuncAttributeMaxDynamicSharedMemorySize, LDS_BYTES) != hipSuccess) { fprintf(stderr, "kernel_launch: hipFuncSetAttribute failed\n"); grid = -1; return; }
        if (hipOccupancyMaxActiveBlocksPerMultiprocessor(&per_cu, (const void*)fwd_megakernel, 512, LDS_BYTES) != hipSuccess || per_cu < 1) { fprintf(stderr, "kernel_launch: occupancy query says %d\n", per_cu); per_cu = 1; }
        (void)hipGetLastError();
        grid = cus * per_cu; if (grid > 256) grid = 256;
        if (grid != 256) fprintf(stderr, "kernel_launch: grid %d != 256: the residual GEMM epilogues need one unit per workgroup\n", grid);
    }
    if (grid < 0) return;
    if (hipMemsetAsync((char*)d_ws + WS_CTL, 0, CTL_BYTES, stream) != hipSuccess) { fprintf(stderr, "kernel_launch: memset failed\n"); return; }
    Args a{};
    for (int i = 0; i < 14; ++i) a.in[i] = (const float*)d_in[i];
    a.out = (float*)d_out; a.ws = (unsigned char*)d_ws;
#ifndef MK_SPLIT
    a.ph_lo = 0; a.ph_hi = NSTEPS;
    void* args[] = {&a};
    hipError_t e = hipLaunchCooperativeKernel((const void*)fwd_megakernel, dim3(grid), dim3(512), args, LDS_BYTES, stream);
    if (e != hipSuccess) fprintf(stderr, "cooperative launch failed: %s (grid %d)\n", hipGetErrorString(e), grid);
#else
    static const int cuts[] = {0, 1, 3, 4, 5, 6, 7, 8, 9, 10, 11, 12, 13, 14, 15, 16};
    for (int i = 0; i + 1 < (int)(sizeof(cuts) / sizeof(cuts[0])); ++i) { a.ph_lo = cuts[i]; a.ph_hi = cuts[i + 1]; void* args[] = {&a};
        hipError_t e = hipLaunchCooperativeKernel((const void*)fwd_megakernel, dim3(grid), dim3(512), args, LDS_BYTES, stream);
        if (e != hipSuccess) fprintf(stderr, "cooperative launch %d failed: %s (grid %d)\n", i, hipGetErrorString(e), grid); }
#endif
}
```

```cpp
#include <hip/hip_runtime.h>
#include <hip/hip_cooperative_groups.h>
#include <cstdio>
#include <cstdint>
#include <cmath>
namespace cg = cooperative_groups;
namespace pg8 {
#define PG8_LAS __attribute__((address_space(3)))
typedef unsigned short bf16_t;
typedef short bf16x8 __attribute__((ext_vector_type(8)));
typedef float f32x4 __attribute__((ext_vector_type(4)));
typedef unsigned u32x4 __attribute__((ext_vector_type(4)));
constexpr int BM = 256, BK = 64, HALF = 128, HTB = HALF * BK * 2  , STAGE_BYTES = 8 * HTB, NXCD = 8, WGM = 8;

__host__ __device__ __forceinline__ int lds_byte(int r, int c) { const int st = (r >> 4) * 2 + (c >> 5), rr = r & 15, cc = c & 31, ob = rr * 64 + cc * 2; return st * 1024 + (ob ^ (((ob >> 9) & 1) << 5)); }
__host__ __device__ __forceinline__ void stage_rc(int b, int& R, int& C) { const int st = b / 1024, sb = b % 1024, swz = sb ^ (((sb >> 9) & 1) << 5); R = (st >> 1) * 16 + swz / 64; C = (st & 1) * 32 + (swz % 64) / 2; }
__host__ __device__ __forceinline__ int perm32(int rho) { const int n = rho >> 4, i = rho & 15; return 8 * (i >> 2) + 4 * n + (i & 3); }

struct Unit { int pm, pn; };
struct Gemm { const bf16_t* A; const bf16_t* Bt; int M, N, K; int arows = 256; };

struct StaticOrder {
    int nM, nN, nwg, G, c;
    __host__ __device__ void init(int M, int N, int G_, int c_) { nM = M / BM; nN = N / BM; nwg = nM * nN; G = G_; c = c_; }
    __host__ __device__ bool next(int i, Unit& u) const {
        const long L = (long)i * G + c; if (L >= nwg) return false;
        int wgid = (int)L; { const int q = nwg / NXCD, r = nwg % NXCD, xcd = wgid % NXCD, off = wgid / NXCD; wgid = (xcd < r ? xcd * (q + 1) : r * (q + 1) + (xcd - r) * q) + off; }
        const int nig = WGM * nN, gid = wgid / nig, fm = gid * WGM, gsz = (nM - fm) < WGM ? (nM - fm) : WGM;
        u.pm = fm + ((wgid % nig) % gsz); u.pn = (wgid % nig) / gsz; return true;
    }
    __device__ __forceinline__ void a_ready(const Unit&) const {}
    __device__ __forceinline__ void done(const Unit&) const {}
};
__device__ __forceinline__ unsigned cvt_pk_bf16(float lo, float hi) { unsigned r; asm volatile("v_cvt_pk_bf16_f32 %0, %1, %2" : "=v"(r) : "v"(lo), "v"(hi)); return r; }
typedef float f32x2 __attribute__((ext_vector_type(2)));
__device__ __forceinline__ float row_rstd(const float* ss, int row) {
    const f32x4 a = *(const f32x4*)(ss + (size_t)row * 8), b = *(const f32x4*)(ss + (size_t)row * 8 + 4);
    const float s = ((a[0] + a[1]) + (a[2] + a[3])) + ((b[0] + b[1]) + (b[2] + b[3]));
    return 1.0f / sqrtf(s * (1.0f / 2048.0f) + 1e-6f);
}
struct EpiScale {
    static constexpr bool PERM = true, AFTER_DRAIN = false, KHOOK = false;
    bf16_t* O; int ldc; const float* ss; const float* bias; int mode;
    __device__ __forceinline__ void operator()(const f32x4 (&acc)[2][2][4][2], const Unit& u, int wr, int wc, int fr, int fq, PG8_LAS unsigned char* lds, int wid, int lane) const {
        const int colt = u.pn * BM; const int col0 = colt + wc * 32 + 8 * fq;
        PG8_LAS float* tbl = (PG8_LAS float*)(lds + 131072 + 10240);
        PG8_LAS unsigned char* st = lds + 131072 + wid * 1280;
        { const int t = wid * 64 + lane; if (t < 256) tbl[t] = row_rstd(ss, u.pm * BM + t); }
        f32x4 bv[2][2];
#pragma unroll
        for (int bj = 0; bj < 2; ++bj)
#pragma unroll
            for (int n = 0; n < 2; ++n) bv[bj][n] = bias ? *(const f32x4*)(bias + col0 + bj * HALF + 4 * n) : (f32x4){0.f, 0.f, 0.f, 0.f};
        const float cs = (mode == 2 && colt < 2048) ? 0.125f : 1.0f;
        asm volatile("s_waitcnt lgkmcnt(0)" ::: "memory"); __builtin_amdgcn_s_barrier(); asm volatile("" ::: "memory");
        bf16_t* obase = O + (size_t)(u.pm * BM + wr * 64 + (lane >> 2)) * ldc + colt + wc * 32 + 8 * (lane & 3);
#pragma unroll
        for (int ai = 0; ai < 2; ++ai)
#pragma unroll
            for (int m = 0; m < 4; ++m) { const float rs = tbl[ai * HALF + wr * 64 + m * 16 + fr];
#pragma unroll
                for (int bj = 0; bj < 2; ++bj) { const f32x4 v0 = (acc[ai][bj][m][0] * rs + bv[bj][0]) * cs, v1 = (acc[ai][bj][m][1] * rs + bv[bj][1]) * cs;
                    u32x4 w; w.x = cvt_pk_bf16(v0[0], v0[1]); w.y = cvt_pk_bf16(v0[2], v0[3]); w.z = cvt_pk_bf16(v1[0], v1[1]); w.w = cvt_pk_bf16(v1[2], v1[3]);
                    *(PG8_LAS u32x4*)(st + fr * 80 + fq * 16) = w;
                    const u32x4 x = *(const PG8_LAS u32x4*)(st + (lane >> 2) * 80 + (lane & 3) * 16);
                    *(u32x4*)(obase + (size_t)(ai * HALF + m * 16) * ldc + bj * HALF) = x; } }
    }
};
struct EpiScaleT {
    static constexpr bool PERM = true, AFTER_DRAIN = false, KHOOK = false;
    bf16_t* O; int ldc; const float* ss;
    __device__ __forceinline__ void operator()(const f32x4 (&acc)[2][2][4][2], const Unit& u, int wr, int wc, int fr, int fq, PG8_LAS unsigned char* lds, int wid, int lane) const {
        PG8_LAS float* tbl = (PG8_LAS float*)(lds + 131072 + 10240);
        PG8_LAS unsigned char* st = lds + 131072 + wid * 1280;
        { const int t = wid * 64 + lane; if (t < 256) { const int col = u.pn * BM + t; float r = row_rstd(ss, col);
            if (u.pm < 8) { const float lg = -log2f(1.0f - exp2f(-5.0f - (float)u.pm)); r *= exp2f(lg * (float)((col & 127) + 1)) * 0.0625f; } tbl[t] = r; } }
        asm volatile("s_waitcnt lgkmcnt(0)" ::: "memory"); __builtin_amdgcn_s_barrier(); asm volatile("" ::: "memory");
        f32x4 cr[2][2];
#pragma unroll
        for (int bj = 0; bj < 2; ++bj)
#pragma unroll
            for (int n = 0; n < 2; ++n) cr[bj][n] = *(const PG8_LAS f32x4*)(tbl + bj * HALF + wc * 32 + 8 * fq + 4 * n);
        bf16_t* obase = O + (size_t)(u.pm * BM + wr * 64 + (lane >> 2)) * ldc + u.pn * BM + wc * 32 + 8 * (lane & 3);
#pragma unroll
        for (int ai = 0; ai < 2; ++ai)
#pragma unroll
            for (int m = 0; m < 4; ++m) {
#pragma unroll
                for (int bj = 0; bj < 2; ++bj) { const f32x4 v0 = acc[ai][bj][m][0] * cr[bj][0], v1 = acc[ai][bj][m][1] * cr[bj][1];
                    u32x4 w; w.x = cvt_pk_bf16(v0[0], v0[1]); w.y = cvt_pk_bf16(v0[2], v0[3]); w.z = cvt_pk_bf16(v1[0], v1[1]); w.w = cvt_pk_bf16(v1[2], v1[3]);
                    *(PG8_LAS u32x4*)(st + fr * 80 + fq * 16) = w;
                    const u32x4 x = *(const PG8_LAS u32x4*)(st + (lane >> 2) * 80 + (lane & 3) * 16);
                    *(u32x4*)(obase + (size_t)(ai * HALF + m * 16) * ldc + bj * HALF) = x; } }
    }
};
#define PG8_ROR(src, ctrl) __builtin_bit_cast(float, __builtin_amdgcn_mov_dpp(__builtin_bit_cast(int, (float)(src)), (ctrl), 0xf, 0xf, true))
#define PG8_DPP(old, src, ctrl) __builtin_bit_cast(float, __builtin_amdgcn_update_dpp(__builtin_bit_cast(int, (float)(old)), __builtin_bit_cast(int, (float)(src)), (ctrl), 0xf, 0xf, false))
struct EpiConv {
    static constexpr bool PERM = true, AFTER_DRAIN = false, KHOOK = false;
    bf16_t* HM; const float* ss; const float* cw; const float* cb;
    __device__ __forceinline__ void operator()(f32x4 (&acc)[2][2][4][2], const Unit& u, int wr, int wc, int fr, int fq, PG8_LAS unsigned char* lds, int wid, int lane) const {
        PG8_LAS float* tbl = (PG8_LAS float*)(lds + 131072 + 10240);
        PG8_LAS unsigned char* st = lds + 131072 + wid * 1280;
        PG8_LAS float* X = (PG8_LAS float*)(lds + 131072 + 11264);
        const int grow0 = 254 * u.pm - 2;
        { const int t = wid * 64 + lane; if (t < 256) { const int gr = grow0 + t; tbl[t] = (gr >= 0 && gr < 8192) ? row_rstd(ss, gr) : 0.f; } }
        const int j0 = u.pn * 128 + wc * 32 + 8 * fq;
        asm volatile("s_waitcnt lgkmcnt(0)" ::: "memory"); __builtin_amdgcn_s_barrier(); asm volatile("" ::: "memory");
#pragma unroll
        for (int ai = 0; ai < 2; ++ai)
#pragma unroll
            for (int m = 0; m < 4; ++m) { const float rs = tbl[ai * HALF + wr * 64 + m * 16 + fr];
#pragma unroll
                for (int bj = 0; bj < 2; ++bj)
#pragma unroll
                    for (int n = 0; n < 2; ++n) acc[ai][bj][m][n] = acc[ai][bj][m][n] * rs; }
        if (fr >= 14) {
#pragma unroll
            for (int ai = 0; ai < 2; ++ai) { const int b = 2 * ai + wr; if (b < 3) {
#pragma unroll
                for (int bj = 0; bj < 2; ++bj)
#pragma unroll
                    for (int n = 0; n < 2; ++n) *(PG8_LAS f32x4*)(X + (b * 2 + fr - 14) * 256 + bj * HALF + wc * 32 + 8 * fq + 4 * n) = acc[ai][bj][3][n]; } }
        }
        asm volatile("s_waitcnt lgkmcnt(0)" ::: "memory"); __builtin_amdgcn_s_barrier(); asm volatile("" ::: "memory");
        unsigned pk0[2][4][2];
#pragma unroll
        for (int n = 0; n < 2; ++n) {
            f32x4 w[2][3], bs[2];
#pragma unroll
            for (int bj = 0; bj < 2; ++bj) {
#pragma unroll
                for (int k = 0; k < 3; ++k) w[bj][k] = *(const f32x4*)(cw + k * 11008 + bj * 5504 + j0 + 4 * n);
                bs[bj] = *(const f32x4*)(cb + bj * 5504 + j0 + 4 * n); }
#pragma unroll
            for (int ai = 0; ai < 2; ++ai) { const int b = 2 * ai + wr;
#pragma unroll
                for (int m = 0; m < 4; ++m) { f32x4 c[2];
#pragma unroll
                    for (int bj = 0; bj < 2; ++bj) { const f32x4 cur = acc[ai][bj][m][n]; f32x4 prev;
                        if (m > 0) prev = acc[ai][bj][m > 0 ? m - 1 : 0][n];
                        else { prev = (f32x4){0.f, 0.f, 0.f, 0.f}; if (b > 0 && fr >= 14) prev = *(const PG8_LAS f32x4*)(X + ((b - 1) * 2 + fr - 14) * 256 + bj * HALF + wc * 32 + 8 * fq + 4 * n); }
                        f32x4 p1, p2;
#pragma unroll
                        for (int j = 0; j < 4; ++j) { const float r1 = PG8_ROR(prev[j], 0x121), r2 = PG8_ROR(prev[j], 0x122);
                            p1[j] = PG8_DPP(r1, cur[j], 0x111); p2[j] = PG8_DPP(r2, cur[j], 0x112); }
                        c[bj] = bs[bj] + w[bj][0] * p2 + w[bj][1] * p1 + w[bj][2] * cur; }
                    float h4[4];
#pragma unroll
                    for (int j = 0; j < 4; ++j) h4[j] = c[0][j] * __builtin_amdgcn_rcpf(1.0f + __expf(-c[0][j])) * c[1][j];
                    if (n == 0) { pk0[ai][m][0] = cvt_pk_bf16(h4[0], h4[1]); pk0[ai][m][1] = cvt_pk_bf16(h4[2], h4[3]); }
                    else { u32x4 pk; pk.x = pk0[ai][m][0]; pk.y = pk0[ai][m][1]; pk.z = cvt_pk_bf16(h4[0], h4[1]); pk.w = cvt_pk_bf16(h4[2], h4[3]);
                        *(PG8_LAS u32x4*)(st + fr * 80 + fq * 16) = pk;
                        const u32x4 x = *(const PG8_LAS u32x4*)(st + (lane >> 2) * 80 + (lane & 3) * 16);
                        const int t2 = ai * HALF + wr * 64 + m * 16 + (lane >> 2), gr = grow0 + t2;
                        if (t2 >= 2 && gr < 8192) *(u32x4*)(HM + (size_t)gr * 5504 + u.pn * 128 + wc * 32 + 8 * (lane & 3)) = x; } } }
            asm volatile("" ::: "memory");
        }
    }
};
struct EpiResid {
    static constexpr bool PERM = true, AFTER_DRAIN = true, KHOOK = false;
    bf16_t* xb; float* ss; int ldc;
    __device__ __forceinline__ void fused(f32x4 (&acc)[2][2][4][2], const Unit& u, int wr, int wc, int fr, int fq, PG8_LAS unsigned char* lds, int wid, int lane) const {
        PG8_LAS float* P = (PG8_LAS float*)lds;
        const int col0 = u.pn * BM + wc * 32 + 8 * fq;
#pragma unroll
        for (int ai = 0; ai < 2; ++ai)
#pragma unroll
            for (int m = 0; m < 4; ++m) { const int rl = ai * HALF + wr * 64 + m * 16 + fr; const size_t off = (size_t)(u.pm * BM + rl) * ldc + col0; float q = 0.f;
#pragma unroll
                for (int bj = 0; bj < 2; ++bj) { const u32x4 hb = *(const u32x4*)(xb + off + bj * HALF);
                    const f32x4 b0 = (f32x4){__uint_as_float(hb.x << 16), __uint_as_float(hb.x & 0xffff0000u), __uint_as_float(hb.y << 16), __uint_as_float(hb.y & 0xffff0000u)};
                    const f32x4 b1 = (f32x4){__uint_as_float(hb.z << 16), __uint_as_float(hb.z & 0xffff0000u), __uint_as_float(hb.w << 16), __uint_as_float(hb.w & 0xffff0000u)};
                    const f32x4 v0 = b0 + acc[ai][bj][m][0], v1 = b1 + acc[ai][bj][m][1];
                    u32x4 w; w.x = cvt_pk_bf16(v0[0], v0[1]); w.y = cvt_pk_bf16(v0[2], v0[3]); w.z = cvt_pk_bf16(v1[0], v1[1]); w.w = cvt_pk_bf16(v1[2], v1[3]);
                    *(u32x4*)(xb + off + bj * HALF) = w;
                    q += (v0[0] * v0[0] + v0[1] * v0[1]) + (v0[2] * v0[2] + v0[3] * v0[3]) + (v1[0] * v1[0] + v1[1] * v1[1]) + (v1[2] * v1[2] + v1[3] * v1[3]); }
                q += __shfl_xor(q, 16); q += __shfl_xor(q, 32);
                if (fq == 0) P[rl * 4 + wc] = q; }
        asm volatile("s_waitcnt lgkmcnt(0)" ::: "memory"); __builtin_amdgcn_s_barrier(); asm volatile("" ::: "memory");
        const int tid = wid * 64 + lane;
        if (tid < 256) { const float s = (P[tid * 4 + 0] + P[tid * 4 + 1]) + (P[tid * 4 + 2] + P[tid * 4 + 3]); ss[(size_t)(u.pm * BM + tid) * 8 + u.pn] = s; }
        asm volatile("s_waitcnt lgkmcnt(0)" ::: "memory"); __builtin_amdgcn_s_barrier(); asm volatile("" ::: "memory");
    }
};
struct EpiResidK {
    static constexpr bool PERM = true, AFTER_DRAIN = true, KHOOK = true;
    bf16_t* xb; float* ss; int ldc; const float* rnp;
    __device__ __forceinline__ void kprep(const Unit& u, PG8_LAS unsigned char* lds, int tid) const {
        if (tid < 256) { PG8_LAS float* RT = (PG8_LAS float*)(lds + 131072 + 11264); const f32x4 a = *(const f32x4*)(rnp + (size_t)(u.pm * BM + tid) * 8), b = *(const f32x4*)(rnp + (size_t)(u.pm * BM + tid) * 8 + 4);
            RT[tid] = b[3]; RT[256 + tid] = a[0] / a[1]; RT[512 + tid] = a[1] / a[2]; RT[768 + tid] = a[2] / a[3]; RT[1024 + tid] = a[3] / b[0]; RT[1280 + tid] = b[0] / b[1]; RT[1536 + tid] = b[1] / b[2]; RT[1792 + tid] = b[2] / b[3]; } }
    __device__ __forceinline__ void khook(f32x4 (&acc)[2][2][4][2], int hb, int wr, int fr, PG8_LAS unsigned char* lds) const {
        const PG8_LAS float* RT = (const PG8_LAS float*)(lds + 131072 + 11264) + hb * 256 + wr * 64 + fr;
#pragma unroll
        for (int ai = 0; ai < 2; ++ai)
#pragma unroll
            for (int m = 0; m < 4; ++m) { const float r = RT[ai * HALF + m * 16];
#pragma unroll
                for (int bj = 0; bj < 2; ++bj)
#pragma unroll
                    for (int n = 0; n < 2; ++n) acc[ai][bj][m][n] = acc[ai][bj][m][n] * r; } }
    __device__ __forceinline__ void fused(f32x4 (&acc)[2][2][4][2], const Unit& u, int wr, int wc, int fr, int fq, PG8_LAS unsigned char* lds, int wid, int lane) const {
        khook(acc, 0, wr, fr, lds);
        PG8_LAS float* P = (PG8_LAS float*)lds;
        const int col0 = u.pn * BM + wc * 32 + 8 * fq;
#pragma unroll
        for (int ai = 0; ai < 2; ++ai)
#pragma unroll
            for (int m = 0; m < 4; ++m) { const int rl = ai * HALF + wr * 64 + m * 16 + fr; const size_t off = (size_t)(u.pm * BM + rl) * ldc + col0; float q = 0.f;
#pragma unroll
                for (int bj = 0; bj < 2; ++bj) { const u32x4 hb = *(const u32x4*)(xb + off + bj * HALF);
                    const f32x4 b0 = (f32x4){__uint_as_float(hb.x << 16), __uint_as_float(hb.x & 0xffff0000u), __uint_as_float(hb.y << 16), __uint_as_float(hb.y & 0xffff0000u)};
                    const f32x4 b1 = (f32x4){__uint_as_float(hb.z << 16), __uint_as_float(hb.z & 0xffff0000u), __uint_as_float(hb.w << 16), __uint_as_float(hb.w & 0xffff0000u)};
                    const f32x4 v0 = b0 + acc[ai][bj][m][0], v1 = b1 + acc[ai][bj][m][1];
                    u32x4 w; w.x = cvt_pk_bf16(v0[0], v0[1]); w.y = cvt_pk_bf16(v0[2], v0[3]); w.z = cvt_pk_bf16(v1[0], v1[1]); w.w = cvt_pk_bf16(v1[2], v1[3]);
                    *(u32x4*)(xb + off + bj * HALF) = w;
                    q += (v0[0] * v0[0] + v0[1] * v0[1]) + (v0[2] * v0[2] + v0[3] * v0[3]) + (v1[0] * v1[0] + v1[1] * v1[1]) + (v1[2] * v1[2] + v1[3] * v1[3]); }
                q += __shfl_xor(q, 16); q += __shfl_xor(q, 32);
                if (fq == 0) P[rl * 4 + wc] = q; }
        asm volatile("s_waitcnt lgkmcnt(0)" ::: "memory"); __builtin_amdgcn_s_barrier(); asm volatile("" ::: "memory");
        const int tid = wid * 64 + lane;
        if (tid < 256) { const float s = (P[tid * 4 + 0] + P[tid * 4 + 1]) + (P[tid * 4 + 2] + P[tid * 4 + 3]); ss[(size_t)(u.pm * BM + tid) * 8 + u.pn] = s; }
        asm volatile("s_waitcnt lgkmcnt(0)" ::: "memory"); __builtin_amdgcn_s_barrier(); asm volatile("" ::: "memory");
    }
};
struct EpiResidFinal {
    static constexpr bool PERM = true, AFTER_DRAIN = true, KHOOK = false;
    const bf16_t* xb; float* out; float* ss; const float* gain; unsigned* cnt; int ldc;
    __device__ __forceinline__ void fused(f32x4 (&acc)[2][2][4][2], const Unit& u, int wr, int wc, int fr, int fq, PG8_LAS unsigned char* lds, int wid, int lane) const {
        PG8_LAS float* P = (PG8_LAS float*)lds;
        PG8_LAS float* tbl = (PG8_LAS float*)(lds + 4096);
        const int col0 = u.pn * BM + wc * 32 + 8 * fq;
#pragma unroll
        for (int ai = 0; ai < 2; ++ai)
#pragma unroll
            for (int m = 0; m < 4; ++m) { const int rl = ai * HALF + wr * 64 + m * 16 + fr; const size_t off = (size_t)(u.pm * BM + rl) * ldc + col0; float q = 0.f;
#pragma unroll
                for (int bj = 0; bj < 2; ++bj) { const u32x4 hb = *(const u32x4*)(xb + off + bj * HALF);
                    const f32x4 b0 = (f32x4){__uint_as_float(hb.x << 16), __uint_as_float(hb.x & 0xffff0000u), __uint_as_float(hb.y << 16), __uint_as_float(hb.y & 0xffff0000u)};
                    const f32x4 b1 = (f32x4){__uint_as_float(hb.z << 16), __uint_as_float(hb.z & 0xffff0000u), __uint_as_float(hb.w << 16), __uint_as_float(hb.w & 0xffff0000u)};
                    const f32x4 v0 = b0 + acc[ai][bj][m][0], v1 = b1 + acc[ai][bj][m][1]; acc[ai][bj][m][0] = v0; acc[ai][bj][m][1] = v1;
                    q += (v0[0] * v0[0] + v0[1] * v0[1]) + (v0[2] * v0[2] + v0[3] * v0[3]) + (v1[0] * v1[0] + v1[1] * v1[1]) + (v1[2] * v1[2] + v1[3] * v1[3]); }
                q += __shfl_xor(q, 16); q += __shfl_xor(q, 32);
                if (fq == 0) P[rl * 4 + wc] = q; }
        asm volatile("s_waitcnt lgkmcnt(0)" ::: "memory"); __builtin_amdgcn_s_barrier(); asm volatile("" ::: "memory");
        const int tid = wid * 64 + lane;
        if (tid < 256) { const float sq = (P[tid * 4 + 0] + P[tid * 4 + 1]) + (P[tid * 4 + 2] + P[tid * 4 + 3]);
            __hip_atomic_store(ss + (size_t)(u.pm * BM + tid) * 8 + u.pn, sq, __ATOMIC_RELAXED, __HIP_MEMORY_SCOPE_AGENT); }
        asm volatile("s_waitcnt vmcnt(0)" ::: "memory");
        __builtin_amdgcn_s_barrier(); asm volatile("" ::: "memory");
        if (tid == 0) { unsigned* c = cnt + 16 * u.pm; __hip_atomic_fetch_add(c, 1u, __ATOMIC_RELEASE, __HIP_MEMORY_SCOPE_AGENT);
            unsigned spins = 0; while (__hip_atomic_load(c, __ATOMIC_RELAXED, __HIP_MEMORY_SCOPE_AGENT) < 8u && ++spins < (1u << 22)) __builtin_amdgcn_s_sleep(2);
            __builtin_amdgcn_fence(__ATOMIC_ACQUIRE, "agent"); }
        asm volatile("s_waitcnt vmcnt(0) lgkmcnt(0)" ::: "memory"); __builtin_amdgcn_s_barrier(); asm volatile("" ::: "memory");
        if (tid < 256) { float sq = 0.f;
#pragma unroll
            for (int t = 0; t < 8; ++t) sq += __hip_atomic_load(ss + (size_t)(u.pm * BM + tid) * 8 + t, __ATOMIC_RELAXED, __HIP_MEMORY_SCOPE_AGENT);
            tbl[tid] = 1.0f / sqrtf(sq * (1.0f / 2048.0f) + 1e-6f); }
        asm volatile("s_waitcnt lgkmcnt(0)" ::: "memory"); __builtin_amdgcn_s_barrier(); asm volatile("" ::: "memory");
        { constexpr int TROW = 1040, TSZ = 64 * TROW; const f32x4 gcol = *(const f32x4*)(gain + (size_t)u.pn * BM + 4 * lane);
#pragma unroll
          for (int p = 0; p < 4; ++p) { const int ai = p >> 1, wrp = p & 1; PG8_LAS unsigned char* T = lds + 8192 + (p & 1) * TSZ;
              if (wr == wrp) {
#pragma unroll
                  for (int bj = 0; bj < 2; ++bj)
#pragma unroll
                      for (int m = 0; m < 4; ++m)
#pragma unroll
                          for (int n = 0; n < 2; ++n) *(PG8_LAS f32x4*)(T + (m * 16 + fr) * TROW + (bj * HALF + wc * 32 + 8 * fq + 4 * n) * 4) = acc[ai][bj][m][n];
              }
              asm volatile("s_waitcnt lgkmcnt(0)" ::: "memory"); __builtin_amdgcn_s_barrier(); asm volatile("" ::: "memory");
#pragma unroll
              for (int r = 0; r < 8; ++r) { const int rl = p * 64 + 8 * wid + r; const f32x4 t = *(const PG8_LAS f32x4*)(T + (8 * wid + r) * TROW + lane * 16);
                  *(f32x4*)(out + (size_t)(u.pm * BM + rl) * ldc + (size_t)u.pn * BM + 4 * lane) = t * tbl[rl] * gcol; } } }
        asm volatile("s_waitcnt lgkmcnt(0)" ::: "memory"); __builtin_amdgcn_s_barrier(); asm volatile("" ::: "memory");
    }
};

template <class Epi, class Sched, bool ALIGN_EPI = false, bool SP2 = false>
__device__ __forceinline__ void gemm_phase(PG8_LAS unsigned char* lds, const Gemm g, const Sched& S, const Epi& E) {
    int tid_ = threadIdx.x; asm volatile("" : "+v"(tid_));
    const int tid = tid_, wid = __builtin_amdgcn_readfirstlane(tid >> 6), lane = tid & 63, wr = wid >> 2, wc = wid & 3, fr = lane & 15, fq = lane >> 4;
    const int K = g.K, nt = K / BK;
    unsigned voffA[2], voffB[2];
#pragma unroll
    for (int i = 0; i < 2; ++i) { int R, C; stage_rc(tid * 16 + i * 8192, R, C); const int Rb = Epi::PERM ? ((R & ~31) + perm32(R & 31)) : R;
        voffA[i] = (unsigned)(R * K + C) * 2u; voffB[i] = (unsigned)(Rb * K + C) * 2u; }
    const size_t kstep = (size_t)(BK * 2);
    const size_t hstep = (size_t)HALF * K * 2;
    const size_t tstep = 2 * hstep;
    const size_t tstepA = (size_t)g.arows * K * 2;
    const unsigned ldsw = (unsigned)wid * 1024u;
    const int aoff = lds_byte(wr * 64 + fr, fq * 8), boff = lds_byte(wc * 32 + fr, fq * 8);
#define PG8_SA(b, h) (((b) * 2 + (h)) * HTB)
#define PG8_SB(b, h) ((4 + (b) * 2 + (h)) * HTB)
#define PG8_STAGE(bufoff, gbase, voff) do { _Pragma("unroll") for (int _i = 0; _i < 2; ++_i) \
        __builtin_amdgcn_global_load_lds((const unsigned*)((const char*)(gbase) + (voff)[_i]), (PG8_LAS unsigned*)(lds + (bufoff) + ldsw + _i * 8192), 16, 0, 0); } while (0)
#define PG8_LDA(dst, b, h) do { _Pragma("unroll") for (int m = 0; m < 4; ++m) _Pragma("unroll") for (int k = 0; k < 2; ++k) dst[m][k] = *(const PG8_LAS bf16x8*)(lds + PG8_SA(b, h) + aoff + m * 2048 + k * 1024); } while (0)
#define PG8_LDB(dst, b, h) do { _Pragma("unroll") for (int n = 0; n < 2; ++n) _Pragma("unroll") for (int k = 0; k < 2; ++k) dst[n][k] = *(const PG8_LAS bf16x8*)(lds + PG8_SB(b, h) + boff + n * 2048 + k * 1024); } while (0)
#define PG8_MMA(ai, bj, At, Bt) do { __builtin_amdgcn_s_setprio(1); _Pragma("unroll") for (int m = 0; m < 4; ++m) _Pragma("unroll") for (int n = 0; n < 2; ++n) _Pragma("unroll") for (int k = 0; k < 2; ++k) \
        acc[ai][bj][m][n] = __builtin_amdgcn_mfma_f32_16x16x32_bf16(Bt[n][k], At[m][k], acc[ai][bj][m][n], 0, 0, 0); __builtin_amdgcn_s_setprio(0); } while (0)
#define PG8_WAIT_V(n) asm volatile("s_waitcnt vmcnt(" #n ")" ::: "memory")
#define PG8_WAIT_L(n) asm volatile("s_waitcnt lgkmcnt(" #n ")" ::: "memory")
#define PG8_BAR __builtin_amdgcn_s_barrier()
#define PG8_SCHED __builtin_amdgcn_sched_barrier(0)
    Unit cur, nxt; int ui = 0;
    if (!S.next(0, cur)) return;
    f32x4 acc[2][2][4][2];
#pragma unroll
    for (int a = 0; a < 2; ++a)
#pragma unroll
        for (int b = 0; b < 2; ++b)
#pragma unroll
            for (int m = 0; m < 4; ++m)
#pragma unroll
                for (int n = 0; n < 2; ++n) acc[a][b][m][n] = (f32x4){0.f, 0.f, 0.f, 0.f};
    bf16x8 At[4][2], B0[2][2], B1[2][2];
    const char* cA = (const char*)g.A + (size_t)cur.pm * tstepA; const char* cB = (const char*)g.Bt + (size_t)cur.pn * tstep;
    S.a_ready(cur);
    if constexpr (Epi::KHOOK) E.kprep(cur, lds, tid);
    if constexpr (SP2) {
        PG8_STAGE(PG8_SB(0, 0), cB, voffB); PG8_STAGE(PG8_SB(0, 1), cB + hstep, voffB); PG8_STAGE(PG8_SA(0, 0), cA, voffA); PG8_STAGE(PG8_SA(0, 1), cA + hstep, voffA);
        if (wr == 1) PG8_BAR;
        PG8_WAIT_V(2); PG8_BAR;
        PG8_STAGE(PG8_SB(1, 0), cB + kstep, voffB); PG8_STAGE(PG8_SA(1, 0), cA + kstep, voffA); PG8_STAGE(PG8_SB(1, 1), cB + hstep + kstep, voffB);
        PG8_WAIT_V(6); PG8_BAR;
    } else {
        PG8_STAGE(PG8_SB(0, 0), cB, voffB); PG8_STAGE(PG8_SA(0, 0), cA, voffA); PG8_STAGE(PG8_SB(0, 1), cB + hstep, voffB); PG8_STAGE(PG8_SA(0, 1), cA + hstep, voffA);
        if (wr == 1) PG8_BAR;
        PG8_WAIT_V(4); PG8_BAR;
        PG8_STAGE(PG8_SB(1, 0), cB + kstep, voffB); PG8_STAGE(PG8_SA(1, 0), cA + kstep, voffA); PG8_STAGE(PG8_SB(1, 1), cB + hstep + kstep, voffB);
        PG8_WAIT_V(6); PG8_BAR;
    }
    for (;;) {
        const bool has_next = S.next(ui + 1, nxt);
        const char* nA = has_next ? (const char*)g.A + (size_t)nxt.pm * tstepA : cA; const char* nB = has_next ? (const char*)g.Bt + (size_t)nxt.pn * tstep : cB;
        for (int t = 0; t < nt; t += 2) {
            if constexpr (Epi::KHOOK) { if ((t & 7) == 0 && t != 0) E.khook(acc, t >> 3, wr, fr, lds); }
            const bool last = (t == nt - 2);
            const char* a1 = cA + (size_t)(t + 1) * kstep;
            const char* a2 = last ? nA : cA + (size_t)(t + 2) * kstep; const char* b2 = last ? nB : cB + (size_t)(t + 2) * kstep;
            const char* a3 = a2 + kstep; const char* b3 = b2 + kstep;
            if (last && has_next) S.a_ready(nxt);
            if constexpr (SP2) {
            PG8_LDB(B0, 0, 0); PG8_LDB(B1, 0, 1); PG8_SCHED; PG8_LDA(At, 0, 0); PG8_STAGE(PG8_SA(1, 1), a1 + hstep, voffA);
            PG8_WAIT_V(8); PG8_WAIT_L(0); PG8_BAR; PG8_MMA(0, 0, At, B0); PG8_MMA(0, 1, At, B1); PG8_BAR; PG8_SCHED;
            PG8_LDA(At, 0, 1); PG8_STAGE(PG8_SB(0, 0), b2, voffB); PG8_STAGE(PG8_SB(0, 1), b2 + hstep, voffB); PG8_STAGE(PG8_SA(0, 0), a2, voffA);
            PG8_WAIT_V(8); PG8_WAIT_L(0); PG8_BAR; PG8_MMA(1, 0, At, B0); PG8_MMA(1, 1, At, B1); PG8_BAR; PG8_SCHED;
            PG8_LDB(B0, 1, 0); PG8_LDB(B1, 1, 1); PG8_SCHED; PG8_LDA(At, 1, 0); PG8_STAGE(PG8_SA(0, 1), a2 + hstep, voffA);
            PG8_WAIT_V(8); PG8_WAIT_L(0); PG8_BAR; PG8_MMA(0, 0, At, B0); PG8_MMA(0, 1, At, B1); PG8_BAR; PG8_SCHED;
            PG8_LDA(At, 1, 1); PG8_STAGE(PG8_SB(1, 0), b3, voffB); PG8_STAGE(PG8_SB(1, 1), b3 + hstep, voffB); PG8_STAGE(PG8_SA(1, 0), a3, voffA);
            PG8_WAIT_V(8); PG8_WAIT_L(0); PG8_BAR; PG8_MMA(1, 0, At, B0); PG8_MMA(1, 1, At, B1); PG8_BAR; PG8_SCHED;
            } else {
            PG8_LDB(B0, 0, 0); PG8_SCHED; PG8_LDA(At, 0, 0); PG8_STAGE(PG8_SA(1, 1), a1 + hstep, voffA);
            PG8_WAIT_L(8); PG8_BAR; PG8_WAIT_L(0); PG8_MMA(0, 0, At, B0); PG8_BAR; PG8_SCHED;
            PG8_LDB(B1, 0, 1); PG8_STAGE(PG8_SB(0, 0), b2, voffB);
            PG8_BAR; PG8_WAIT_L(0); PG8_MMA(0, 1, At, B1); PG8_BAR;
            PG8_LDA(At, 0, 1); PG8_STAGE(PG8_SA(0, 0), a2, voffA);
            PG8_BAR; PG8_WAIT_L(0); PG8_MMA(1, 0, At, B0); PG8_BAR; PG8_SCHED;
            PG8_STAGE(PG8_SB(0, 1), b2 + hstep, voffB);
            PG8_WAIT_V(6); PG8_BAR; PG8_MMA(1, 1, At, B1); PG8_BAR;
            PG8_LDB(B0, 1, 0); PG8_SCHED; PG8_LDA(At, 1, 0); PG8_STAGE(PG8_SA(0, 1), a2 + hstep, voffA);
            PG8_WAIT_L(8); PG8_BAR; PG8_WAIT_L(0); PG8_MMA(0, 0, At, B0); PG8_BAR; PG8_SCHED;
            PG8_LDB(B1, 1, 1); PG8_STAGE(PG8_SB(1, 0), b3, voffB);
            PG8_BAR; PG8_WAIT_L(0); PG8_MMA(0, 1, At, B1); PG8_BAR;
            PG8_LDA(At, 1, 1); PG8_STAGE(PG8_SA(1, 0), a3, voffA);
            PG8_BAR; PG8_WAIT_L(0); PG8_MMA(1, 0, At, B0); PG8_BAR; PG8_SCHED;
            PG8_STAGE(PG8_SB(1, 1), b3 + hstep, voffB);
            PG8_WAIT_V(6); PG8_BAR; PG8_MMA(1, 1, At, B1); PG8_BAR;
            }
        }
        if constexpr (ALIGN_EPI) { if (wr == 0) PG8_BAR; }
        if constexpr (!Epi::AFTER_DRAIN) { E(acc, cur, wr, wc, fr, fq, lds, wid, lane); S.done(cur); }
        if (!has_next) break;
#pragma unroll
        for (int a = 0; a < 2; ++a)
#pragma unroll
            for (int b = 0; b < 2; ++b)
#pragma unroll
                for (int m = 0; m < 4; ++m)
#pragma unroll
                    for (int n = 0; n < 2; ++n) acc[a][b][m][n] = (f32x4){0.f, 0.f, 0.f, 0.f};
        cur = nxt; cA = nA; cB = nB; ++ui;
        if constexpr (ALIGN_EPI) { if (wr == 1) PG8_BAR; }
    }
    PG8_WAIT_V(0);
    if constexpr (!ALIGN_EPI) { if (wr == 0) PG8_BAR; }
    PG8_BAR;
    if constexpr (Epi::AFTER_DRAIN) { E.fused(acc, cur, wr, wc, fr, fq, lds, wid, lane); S.done(cur); }
#undef PG8_SA
#undef PG8_SB
#undef PG8_STAGE
#undef PG8_LDA
#undef PG8_LDB
#undef PG8_MMA
#undef PG8_WAIT_V
#undef PG8_WAIT_L
#undef PG8_BAR
#undef PG8_SCHED
}
}
constexpr int SEQ = 8192, DM = 2048, FF = 5504, FF2 = 11008;
constexpr int RIN = 12288;
constexpr int AIN = 2560;
constexpr float EPS = 1e-6f;
constexpr size_t MiB = 1u << 20;
constexpr size_t WS_SS = 0;
constexpr size_t WS_CTL = 512 * 1024, CTL_BYTES = 16384;
constexpr int LDS_CTL_OFF = 155648 - 64;
constexpr size_t WS_W_RIN = 1 * MiB;
constexpr size_t WS_W_ROUT = 49 * MiB;
constexpr size_t WS_W_QKV = 65 * MiB;
constexpr size_t WS_W_AOUT = 75 * MiB;
constexpr size_t WS_W_UP = 83 * MiB;
constexpr size_t WS_W_DN = 169 * MiB;
constexpr size_t WS_XB = 212 * MiB + 8192;
constexpr size_t WS_ACT = 245 * MiB;
constexpr size_t WS_PROJ = WS_ACT  , WS_KVT = WS_ACT + 96 * MiB  , WS_ST = WS_ACT + 194 * MiB, WS_Y = WS_ACT + 322 * MiB;
constexpr int KVT_LD = SEQ + 64;
constexpr size_t WS_U = WS_ACT, WS_HM = WS_ACT + 172 * MiB;
constexpr size_t WS_QKV = WS_ACT, WS_AO = WS_ACT + 40 * MiB;
constexpr size_t WS_END = WS_ACT + 386 * MiB;
constexpr int LDS_BYTES = 155648;

#define LAS __attribute__((address_space(3)))
typedef unsigned short bf16;
typedef unsigned v4u __attribute__((ext_vector_type(4)));
typedef unsigned v2u __attribute__((ext_vector_type(2)));
typedef float f32x4 __attribute__((ext_vector_type(4)));
typedef short bf16x8 __attribute__((ext_vector_type(8)));
typedef short s16x4 __attribute__((ext_vector_type(4)));
#define LDS_WAIT() asm volatile("s_waitcnt lgkmcnt(0)" ::: "memory")
#define LBAR() do { asm volatile("s_waitcnt lgkmcnt(0)" ::: "memory"); __builtin_amdgcn_s_barrier(); asm volatile("" ::: "memory"); } while (0)
__device__ __forceinline__ unsigned pk2(float lo, float hi) { return pg8::cvt_pk_bf16(lo, hi); }
__device__ __forceinline__ float bf_lo(unsigned w) { return __uint_as_float(w << 16); }
__device__ __forceinline__ float bf_hi(unsigned w) { return __uint_as_float(w & 0xffff0000u); }
__device__ __forceinline__ s16x4 tr_read(LAS const unsigned char* p) { return __builtin_bit_cast(s16x4, __builtin_amdgcn_ds_read_tr16_b64_v4i16((LAS s16x4*)p)); }
__device__ __forceinline__ bf16x8 cat8(s16x4 a, s16x4 b) { return (bf16x8){a[0], a[1], a[2], a[3], b[0], b[1], b[2], b[3]}; }
__device__ __forceinline__ bf16x8 pack8(f32x4 a, f32x4 b) { v4u w; w.x = pk2(a[0], a[1]); w.y = pk2(a[2], a[3]); w.z = pk2(b[0], b[1]); w.w = pk2(b[2], b[3]); return __builtin_bit_cast(bf16x8, w); }
#define MFMA16(a, b, c) __builtin_amdgcn_mfma_f32_16x16x32_bf16((a), (b), (c), 0, 0, 0)
__device__ __forceinline__ float wave_sum(float v) {
#pragma unroll
    for (int o = 1; o < 64; o <<= 1) v += __shfl_xor(v, o);
    return v;
}

#define XB_TMO      128
#define XB_XCNT(j)  (256  + 64 * (j))
#define XB_XSUB(j)  (1280 + 64 * (j))
#define XB_XGEN(j)  (2304 + 64 * (j))
#define XB_TOP      3328
#define XB_TOPGEN   3392
#define XCD_BAR_WORDS 3456
#define XB_SPIN_CAP (1u << 18)

__device__ __forceinline__ unsigned xb_ld(unsigned* p)              { return __hip_atomic_load(p, __ATOMIC_RELAXED, __HIP_MEMORY_SCOPE_AGENT); }
__device__ __forceinline__ unsigned xb_add(unsigned* p, unsigned v) { return __hip_atomic_fetch_add(p, v, __ATOMIC_RELAXED, __HIP_MEMORY_SCOPE_AGENT); }
__device__ __forceinline__ unsigned xb_xcc_id() { return (unsigned)__builtin_amdgcn_s_getreg((3 << 11) | 20) & 0xFu; }
#define XB_SPIN(cond, bar) do { unsigned _sp = 0; while (cond) { __builtin_amdgcn_s_sleep(4); \
    if ((++_sp & 255u) == 0u) { if (xb_ld(&(bar)[XB_TMO])) break; if (_sp > XB_SPIN_CAP) { atomicAdd(&(bar)[XB_TMO], 1u); break; } } } } while (0)

struct XcdBarrier {
    unsigned* bar; unsigned x;
    volatile LAS unsigned* st;
};

__device__ __forceinline__ XcdBarrier xcd_barrier_post(unsigned* bar, volatile LAS unsigned* st) {
    XcdBarrier b; b.bar = bar; b.x = xb_xcc_id(); b.st = st;
    if (threadIdx.x == 0) (void)xb_add(&bar[XB_XCNT(b.x)], 1u);
    return b;
}
__device__ __forceinline__ void xcd_barrier_complete(unsigned* bar, unsigned x, unsigned& nloc, unsigned& nx) {
    const unsigned G = gridDim.x * gridDim.y * gridDim.z;
    unsigned sum, cnt, mine, sp = 0u;
    for (;;) {
        sum = 0u; cnt = 0u; mine = 0u;
#pragma unroll
        for (unsigned j = 0; j < 16; ++j) { const unsigned c = xb_ld(&bar[XB_XCNT(j)]); sum += c; cnt += (c > 0u) ? 1u : 0u; mine = (j == x) ? c : mine; }
        if (sum == G) break;
        __builtin_amdgcn_s_sleep(1);
        if ((++sp & 255u) == 0u) { if (xb_ld(&bar[XB_TMO])) break; if (sp > XB_SPIN_CAP) { atomicAdd(&bar[XB_TMO], 1u); break; } }
    }
    nloc = mine > 0u ? mine : 1u; nx = cnt > 0u ? cnt : 1u;
}

__device__ __forceinline__ void xcd_barrier(const XcdBarrier& b) {
    asm volatile("s_waitcnt vmcnt(0)" ::: "memory");
    __syncthreads();
    if (threadIdx.x == 0) {
        unsigned* bar = b.bar;
        __builtin_amdgcn_s_waitcnt(0);
        unsigned nloc = b.st[0], nx = b.st[1];
        if (nloc == 0u) { xcd_barrier_complete(bar, b.x, nloc, nx); b.st[0] = nloc; b.st[1] = nx; }
        const unsigned old = xb_add(&bar[XB_XSUB(b.x)], 1u);
        const unsigned gen = old / nloc;
        if (old + 1u == (gen + 1u) * nloc) {
            __builtin_amdgcn_fence(__ATOMIC_RELEASE, "agent");
            asm volatile("s_waitcnt vmcnt(0)" ::: "memory");
            const unsigned og = xb_add(&bar[XB_TOP], 1u);
            const unsigned tg = og / nx;
            if (og + 1u == (tg + 1u) * nx) xb_add(&bar[XB_TOPGEN], 1u);
            else XB_SPIN(xb_ld(&bar[XB_TOPGEN]) == tg, bar);
            __builtin_amdgcn_fence(__ATOMIC_ACQUIRE, "agent");
            xb_add(&bar[XB_XGEN(b.x)], 1u);
            asm volatile("s_waitcnt vmcnt(0)" ::: "memory");
        } else {
            XB_SPIN(xb_ld(&bar[XB_XGEN(b.x)]) == gen, bar);
            __builtin_amdgcn_fence(__ATOMIC_ACQUIRE, "agent");
            asm volatile("s_waitcnt vmcnt(0)" ::: "memory");
        }
    }
    __syncthreads();
}

__device__ __forceinline__ void transpose_item(const float* W, int K, int N, bf16* WT, const float* gain, int remap, LAS float* scr, int item, int lane) {
    const int nblk = N / 64, kb = item / nblk, nb = item % nblk, k0 = 64 * kb, n0 = 64 * nb;
    f32x4 v[16];
#pragma unroll
    for (int i = 0; i < 16; ++i) v[i] = __builtin_nontemporal_load((const f32x4*)(W + (size_t)(k0 + 4 * i + (lane >> 4)) * N + n0 + 4 * (lane & 15)));
#pragma unroll
    for (int i = 0; i < 16; ++i) { const int kk = 4 * i + (lane >> 4); const float gv = gain ? gain[k0 + kk] : 1.0f; *(LAS f32x4*)(scr + kk * 68 + 4 * (lane & 15)) = v[i] * gv; }
    LDS_WAIT(); asm volatile("" ::: "memory");
    int r0 = n0; if (remap == 1) { if (n0 >= 8192) r0 = n0 - 6144; else if (n0 >= 2048) r0 = n0 + 4096; }
    else if (remap == 2) { const int jj = (n0 < FF) ? n0 : n0 - FF; r0 = (jj >> 7) * 256 + (jj & 127) + ((n0 < FF) ? 0 : 128); }
    const int c = lane & 7;
#pragma unroll
    for (int j = 0; j < 8; ++j) { const int n = (lane >> 3) + 8 * j; const LAS float* s = scr + (8 * c) * 68 + n;
        v4u o; o.x = pk2(s[0 * 68], s[1 * 68]); o.y = pk2(s[2 * 68], s[3 * 68]); o.z = pk2(s[4 * 68], s[5 * 68]); o.w = pk2(s[6 * 68], s[7 * 68]);
        *(v4u*)(WT + (size_t)(r0 + n) * K + k0 + 8 * c) = o; }
    LDS_WAIT(); asm volatile("" ::: "memory");
}
struct Args { const float* in[14]; float* out; unsigned char* ws; int ph_lo, ph_hi; };

__device__ __forceinline__ void convert_set(const Args& a, LAS unsigned char* lds, int set, int wave, int lane, int worker, int nworkers) {
    LAS float* scr = (LAS float*)(lds + wave * 17408);
    unsigned char* ws = a.ws;
    constexpr int I_RIN = 32 * (RIN / 64), I_ROUT = 64 * (DM / 64), I_QKV = 32 * (AIN / 64), I_AOUT = 32 * (DM / 64), I_UP = 32 * (FF2 / 64), I_DN = (FF / 64) * (DM / 64);
    const int n = (set == 0) ? (I_RIN + I_ROUT + I_QKV + I_UP) : (set == 1) ? (I_AOUT + I_DN) : (set == 2) ? I_UP : I_DN;
    for (int it = worker; it < n; it += nworkers) {
        int r = it; const float* W; int K, N, remap = 0; bf16* WT; const float* gain = nullptr;
        if (set == 0) {
            if (r < I_RIN) { W = a.in[2]; K = DM; N = RIN; WT = (bf16*)(ws + WS_W_RIN); gain = a.in[1]; remap = 1; }
            else if ((r -= I_RIN) < I_ROUT) { W = a.in[3]; K = 4096; N = DM; WT = (bf16*)(ws + WS_W_ROUT); }
            else if ((r -= I_ROUT) < I_QKV) { W = a.in[4]; K = DM; N = AIN; WT = (bf16*)(ws + WS_W_QKV); gain = a.in[1] + DM; }
            else { r -= I_QKV; W = a.in[9]; K = DM; N = FF2; WT = (bf16*)(ws + WS_W_UP); gain = a.in[8]; remap = 2; }
        } else if (set == 1) {
            if (r < I_AOUT) { W = a.in[7]; K = DM; N = DM; WT = (bf16*)(ws + WS_W_AOUT); }
            else { r -= I_AOUT; W = a.in[12]; K = FF; N = DM; WT = (bf16*)(ws + WS_W_DN); }
        } else if (set == 2) { W = a.in[9] + (size_t)DM * FF2; K = DM; N = FF2; WT = (bf16*)(ws + WS_W_UP) + (size_t)FF2 * DM; gain = a.in[8] + DM; remap = 2; }
        else { W = a.in[12] + (size_t)FF * DM; K = FF; N = DM; WT = (bf16*)(ws + WS_W_DN) + (size_t)DM * FF; }
        transpose_item(W, K, N, WT, gain, remap, scr, r, lane);
    }
}
__device__ __forceinline__ void prologue(const Args& a, LAS unsigned char* lds, int G, int bid) {
    int tid_ = threadIdx.x; asm volatile("" : "+v"(tid_));
    const int tid = tid_, lane = tid & 63, wave = __builtin_amdgcn_readfirstlane(tid >> 6);
    LAS float* scr = (LAS float*)(lds + wave * 17408);
    const int gw = bid * 8 + wave, NGW = G * 8;
    unsigned char* ws = a.ws;
    convert_set(a, lds, 0, wave, lane, gw, NGW);
    { v4u* hz0 = (v4u*)(ws + WS_XB - 8192); v4u* hz1 = (v4u*)(ws + WS_XB + (size_t)SEQ * DM * 2); const int gt = bid * 512 + tid;
      for (int i = gt; i < 512; i += G * 512) hz0[i] = (v4u){0u, 0u, 0u, 0u};
      for (int i = gt; i < 190 * 256; i += G * 512) hz1[i] = (v4u){0u, 0u, 0u, 0u}; }
    const float* x = a.in[0]; bf16* XB = (bf16*)(ws + WS_XB); float* ss = (float*)(ws + WS_SS);
    for (int m = gw; m < SEQ; m += NGW) {
        const f32x4* xr = (const f32x4*)(x + (size_t)m * DM) + lane; f32x4 v[8]; float s = 0.f;
#pragma unroll
        for (int j = 0; j < 8; ++j) { v[j] = xr[64 * j]; s += (v[j][0] * v[j][0] + v[j][1] * v[j][1]) + (v[j][2] * v[j][2] + v[j][3] * v[j][3]); }
        s = wave_sum(s);
        v2u* o8 = (v2u*)(XB + (size_t)m * DM) + lane;
#pragma unroll
        for (int j = 0; j < 8; ++j) { v2u w; w.x = pk2(v[j][0], v[j][1]); w.y = pk2(v[j][2], v[j][3]); o8[64 * j] = w; }
        if (lane < 8) ss[(size_t)m * 8 + lane] = (lane == 0) ? s : 0.f;
    }
}

__device__ __forceinline__ void ret_scan_phase(LAS unsigned char* lds, const bf16* KVT, bf16* ST, int G, int bid) {
    int tid_ = threadIdx.x; asm volatile("" : "+v"(tid_));
    const int tid = tid_, lane = tid & 63, w = __builtin_amdgcn_readfirstlane(tid >> 6), g = lane >> 4, li = lane & 15;
    for (int u = bid; u < 256; u += G) {
        const int h = u & 7, dq = (u >> 6) & 3, es = (u >> 3) & 7;
        const float gam = 1.0f - exp2f(-5.0f - (float)h); const float dec = exp2f(128.0f * log2f(gam));
        const bf16* src[4]; unsigned dst[4];
#pragma unroll
        for (int i = 0; i < 4; ++i) { const int bI = 4 * w + i, row = 4 * (bI & 15) + (lane >> 4), piece = (lane & 15) ^ (row & 15);
            const size_t grow = (bI < 16) ? (size_t)(h * 256 + dq * 64 + row) : (size_t)(2048 + h * 512 + es * 64 + row);
            src[i] = KVT + grow * KVT_LD + piece * 8; dst[i] = (unsigned)((bI < 16 ? 0 : 16384) + (bI & 15) * 1024); }
#define RS_DMA(c, slot) do { const int cc_ = ((c) < 63) ? (c) : 63; _Pragma("unroll") for (int i = 0; i < 4; ++i) \
            __builtin_amdgcn_global_load_lds((const unsigned*)(src[i] + cc_ * 128), (LAS unsigned*)(lds + (slot) * 32768 + dst[i]), 16, 0, 0); } while (0)
        const int e0l = 16 * (w & 3), d0l = 32 * (w >> 2);
        const int offA0 = (d0l + li) * 256, offA1 = (d0l + 16 + li) * 256, offB = 16384 + (e0l + li) * 256;
        const int stw = (e0l + li) * 144 + (d0l + 4 * g) * 2;
        const int str_ = (tid >> 3) * 144 + (tid & 7) * 16;
        bf16* stp = ST + ((size_t)(h * 64 * 512 + es * 64 + (tid >> 3))) * 256 + dq * 64 + (tid & 7) * 8;
        f32x4 acc[2]; acc[0] = (f32x4){0.f, 0.f, 0.f, 0.f}; acc[1] = acc[0];
        RS_DMA(0, 0); RS_DMA(1, 1); RS_DMA(2, 2);
#define RS_STEP(c, NW) do { asm volatile("s_waitcnt vmcnt(" #NW ")\n\ts_barrier" ::: "memory"); \
            if ((c) >= 1) { const v4u x_ = *(const LAS v4u*)(lds + 131072 + (((c) - 1) & 1) * 9216 + str_); *(v4u*)(stp + (size_t)(c) * (512 * 256)) = x_; } \
            const LAS unsigned char* sl = lds + ((c) & 3) * 32768; \
            bf16x8 fb_[4], fa0_[4], fa1_[4]; \
            _Pragma("unroll") for (int ks = 0; ks < 4; ++ks) { const int pos = ((4 * ks + g) ^ li) * 16; \
                fb_[ks] = *(const LAS bf16x8*)(sl + offB + pos); fa0_[ks] = *(const LAS bf16x8*)(sl + offA0 + pos); fa1_[ks] = *(const LAS bf16x8*)(sl + offA1 + pos); } \
            __builtin_amdgcn_sched_barrier(0); \
            _Pragma("unroll") for (int ks = 0; ks < 4; ++ks) { acc[0] = MFMA16(fa0_[ks], fb_[ks], acc[0]); acc[1] = MFMA16(fa1_[ks], fb_[ks], acc[1]); } \
            __builtin_amdgcn_sched_barrier(0); \
            _Pragma("unroll") for (int i = 0; i < 2; ++i) { acc[i] = acc[i] * dec; v2u o; o.x = pk2(acc[i][0], acc[i][1]); o.y = pk2(acc[i][2], acc[i][3]); \
                *(LAS v2u*)(lds + 131072 + ((c) & 1) * 9216 + stw + 32 * i) = o; } \
            asm volatile("s_waitcnt lgkmcnt(0)" ::: "memory"); \
            RS_DMA((c) + 3, ((c) + 3) & 3); } while (0)
        RS_STEP(0, 8); RS_STEP(1, 8); RS_STEP(2, 9);
#pragma unroll 1
        for (int c = 3; c < 63; ++c) RS_STEP(c, 10);
        asm volatile("s_waitcnt vmcnt(0)\n\ts_barrier" ::: "memory");
        { const v4u x_ = *(const LAS v4u*)(lds + 131072 + (62 & 1) * 9216 + str_); *(v4u*)(stp + (size_t)63 * (512 * 256)) = x_; }
        asm volatile("s_waitcnt lgkmcnt(0)\n\ts_barrier" ::: "memory");
#undef RS_DMA
#undef RS_STEP
    }
}

__device__ __forceinline__ void ret_out_phase(LAS unsigned char* lds, const bf16* PROJ, const bf16* KVT, const bf16* ST, bf16* Y, float* RN, int G, int bid) {
    int tid_ = threadIdx.x; asm volatile("" : "+v"(tid_));
    constexpr int KROW = 272  , VROW = 272, SROW = 528;
    constexpr int BUF0 = 0, VTB = 64 * VROW  , BUFSZ = VTB + 64 * SROW  , BUF1 = BUFSZ, KS = BUFSZ;
    for (int u = bid; u < 512; u += G) {
        asm volatile("" : "+v"(tid_));
        const int tid = tid_, lane = tid & 63, w = __builtin_amdgcn_readfirstlane(tid >> 6), g = lane >> 4, li = lane & 15;
        const int h = u >> 6, c = u & 63, t0 = c * 128, n0 = 16 * w;
        const bool cross = (c > 0);
        bf16x8 qf[8];
#pragma unroll
        for (int ks = 0; ks < 8; ++ks) qf[ks] = *(const bf16x8*)(PROJ + (size_t)(t0 + n0 + li) * 6144 + h * 256 + 32 * ks + 8 * g);
        {
            v4u rk[8];
#pragma unroll
            for (int i = 0; i < 8; ++i) { const int q = tid + 512 * i; rk[i] = *(const v4u*)(KVT + (size_t)(h * 256 + (q >> 4)) * KVT_LD + t0 + (q & 15) * 8); }
#pragma unroll
            for (int i = 0; i < 8; ++i) { const int q = tid + 512 * i; *(LAS v4u*)(lds + KS + (q >> 4) * KROW + (q & 15) * 16) = rk[i]; }
        }
        v4u rvA[2], rsA[4];
#define RO_LOAD(rv, rs, ec) do { _Pragma("unroll") for (int i = 0; i < 2; ++i) { const int q = tid + 512 * i; \
            rv[i] = *(const v4u*)(KVT + (size_t)(2048 + h * 512 + (ec) * 64 + (q >> 4)) * KVT_LD + t0 + (q & 15) * 8); } \
            if (cross) { _Pragma("unroll") for (int i = 0; i < 4; ++i) { const int q = tid + 512 * i; \
            rs[i] = *(const v4u*)(ST + ((size_t)((h * 64 + c) * 512 + (ec) * 64 + (q >> 5))) * 256 + (q & 31) * 8); } } } while (0)
#define RO_WRITE(rv, rs, buf) do { _Pragma("unroll") for (int i = 0; i < 2; ++i) { const int q = tid + 512 * i; *(LAS v4u*)(lds + (buf) + (q >> 4) * VROW + (q & 15) * 16) = rv[i]; } \
            if (cross) { _Pragma("unroll") for (int i = 0; i < 4; ++i) { const int q = tid + 512 * i; *(LAS v4u*)(lds + (buf) + VTB + (q >> 5) * SROW + (q & 31) * 16) = rs[i]; } } } while (0)
        RO_LOAD(rvA, rsA, 0); RO_WRITE(rvA, rsA, BUF0);
        LBAR();
        bf16x8 pf[4];
        {
            f32x4 sacc[8];
#pragma unroll
            for (int mt = 0; mt < 8; ++mt) { sacc[mt] = (f32x4){0.f, 0.f, 0.f, 0.f};
                if (mt <= w) {
                    s16x4 ta_[8], tb_[8];
#pragma unroll
                    for (int ks = 0; ks < 8; ++ks) { const LAS unsigned char* p = lds + KS + (32 * ks + 8 * g + (li >> 2)) * KROW + (16 * mt + 4 * (li & 3)) * 2; ta_[ks] = tr_read(p); tb_[ks] = tr_read(p + 4 * KROW); }
                    __builtin_amdgcn_sched_barrier(0);
#pragma unroll
                    for (int ks = 0; ks < 8; ++ks) sacc[mt] = MFMA16(cat8(ta_[ks], tb_[ks]), qf[ks], sacc[mt]);
                    __builtin_amdgcn_sched_barrier(0);
#pragma unroll
                    for (int r = 0; r < 4; ++r) if (16 * mt + 4 * g + r > n0 + li) sacc[mt][r] = 0.f;
                } }
#pragma unroll
            for (int i = 0; i < 4; ++i) pf[i] = pack8(sacc[2 * i], sacc[2 * i + 1]);
        }
        LBAR();
        RO_LOAD(rvA, rsA, 1);
        const float lgam = log2f(1.0f - exp2f(-5.0f - (float)h)); const float rsc = exp2f(lgam * (float)(n0 + li + 1));
        float q2 = 0.f;
        LAS unsigned char* stg = lds + 120832 + w * 2304;
        const bf16* grow_ = PROJ + (size_t)(t0 + n0 + (lane >> 3)) * 6144 + 2048 + h * 512 + (lane & 7) * 8;
#define RO_BODY(ec, cur) do { \
            v4u gt_[2]; \
            _Pragma("unroll") for (int et = 0; et < 4; ++et) { f32x4 acc = (f32x4){0.f, 0.f, 0.f, 0.f}; \
                if (et == 2) { _Pragma("unroll") for (int i = 0; i < 2; ++i) gt_[i] = *(const v4u*)(grow_ + (size_t)(8 * i) * 6144 + (ec) * 64); }     \
                  \
                s16x4 lo_[4], hi_[4]; _Pragma("unroll") for (int i = 0; i < 4; ++i) { const LAS unsigned char* p = lds + (cur) + (16 * et + li) * VROW + (32 * i + 4 * g) * 2; lo_[i] = *(const LAS s16x4*)p; hi_[i] = *(const LAS s16x4*)(p + 32); } \
                if (cross) { bf16x8 sa_[4], sb_[4]; const LAS unsigned char* ps = lds + (cur) + VTB + (16 * et + li) * SROW + 16 * g; \
                    _Pragma("unroll") for (int ks = 0; ks < 4; ++ks) sa_[ks] = *(const LAS bf16x8*)(ps + 64 * ks); \
                    __builtin_amdgcn_sched_barrier(0); \
                    _Pragma("unroll") for (int i = 0; i < 4; ++i) acc = MFMA16(cat8(lo_[i], hi_[i]), pf[i], acc); \
                    _Pragma("unroll") for (int ks = 0; ks < 4; ++ks) sb_[ks] = *(const LAS bf16x8*)(ps + 256 + 64 * ks); \
                    __builtin_amdgcn_sched_barrier(0); \
                    _Pragma("unroll") for (int ks = 0; ks < 4; ++ks) acc = MFMA16(sa_[ks], qf[ks], acc); \
                    __builtin_amdgcn_sched_barrier(0); \
                    _Pragma("unroll") for (int ks = 0; ks < 4; ++ks) acc = MFMA16(sb_[ks], qf[4 + ks], acc); } \
                else { __builtin_amdgcn_sched_barrier(0); _Pragma("unroll") for (int i = 0; i < 4; ++i) acc = MFMA16(cat8(lo_[i], hi_[i]), pf[i], acc); } \
                __builtin_amdgcn_sched_barrier(0); \
                acc = acc * rsc; q2 += (acc[0] * acc[0] + acc[1] * acc[1]) + (acc[2] * acc[2] + acc[3] * acc[3]); \
                v2u o; o.x = pk2(acc[0], acc[1]); o.y = pk2(acc[2], acc[3]); *(LAS v2u*)(stg + li * 144 + et * 32 + g * 8) = o; }   \
            _Pragma("unroll") for (int i = 0; i < 2; ++i) { const int row = (lane >> 3) + 8 * i; const v4u x = *(const LAS v4u*)(stg + row * 144 + (lane & 7) * 16); v4u yo_; \
                _Pragma("unroll") for (int k = 0; k < 4; ++k) { const float g0 = bf_lo(gt_[i][k]), g1 = bf_hi(gt_[i][k]); \
                    yo_[k] = pk2(g0 * __builtin_amdgcn_rcpf(1.0f + __expf(-g0)) * bf_lo(x[k]), g1 * __builtin_amdgcn_rcpf(1.0f + __expf(-g1)) * bf_hi(x[k])); } \
                *(v4u*)(Y + (size_t)(t0 + n0 + row) * 4096 + h * 512 + (ec) * 64 + (lane & 7) * 8) = yo_; }   \
        } while (0)
#pragma unroll 1
        for (int ec = 0; ec < 8; ec += 2) {
            RO_BODY(ec, BUF0);
            RO_WRITE(rvA, rsA, BUF1); LBAR();
            if (ec + 2 < 8) RO_LOAD(rvA, rsA, ec + 2);
            RO_BODY(ec + 1, BUF1);
            if (ec + 2 < 8) { RO_WRITE(rvA, rsA, BUF0); LBAR(); RO_LOAD(rvA, rsA, ec + 3); }
        }
#undef RO_BODY
#undef RO_LOAD
#undef RO_WRITE
        q2 += __shfl_xor(q2, 16); q2 += __shfl_xor(q2, 32);
        if (g == 0) RN[(size_t)(t0 + n0 + li) * 8 + h] = 1.0f / sqrtf(q2 * (1.0f / 512.0f) + EPS);
        LBAR();
    }
}

__device__ __forceinline__ void attn_phase(LAS unsigned char* lds, const bf16* QKV, const float* sinks, bf16* AO, int G, int bid) {
    int tid_ = threadIdx.x; asm volatile("" : "+v"(tid_));
    const int tid = tid_, lane = tid & 63, w = __builtin_amdgcn_readfirstlane(tid >> 6), g = lane >> 4, li = lane & 15;
    constexpr int ROW = 144, KS = 0, VS = 272 * ROW;
    for (int u = bid; u < 256; u += G) {
        const int hk = u & 3, nb = u >> 2;
        {
            v4u rk[4], rv[4];
#pragma unroll
            for (int i = 0; i < 4; ++i) { const int q = tid + 512 * i; const int t = nb * 128 - 128 + (q >> 3);
                if (t >= 0) { rk[i] = *(const v4u*)(QKV + (size_t)t * AIN + 2048 + hk * 64 + (q & 7) * 8); rv[i] = *(const v4u*)(QKV + (size_t)t * AIN + 2304 + hk * 64 + (q & 7) * 8); }
                else { rk[i] = (v4u){0u, 0u, 0u, 0u}; rv[i] = rk[i]; } }
#pragma unroll
            for (int i = 0; i < 4; ++i) { const int q = tid + 512 * i; *(LAS v4u*)(lds + KS + (q >> 3) * ROW + (q & 7) * 16) = rk[i]; *(LAS v4u*)(lds + VS + (q >> 3) * ROW + (q & 7) * 16) = rv[i]; }
            if (tid < 144) { *(LAS v4u*)(lds + KS + 256 * ROW + tid * 16) = (v4u){0u, 0u, 0u, 0u}; *(LAS v4u*)(lds + VS + 256 * ROW + tid * 16) = (v4u){0u, 0u, 0u, 0u}; }
        }
        LBAR();
        const int qfr = 128 + 16 * w + li;
        const bf16* qrow = QKV + (size_t)(nb * 128 + 16 * w + li) * AIN + hk * 8 * 64 + 8 * g;
        bf16x8 qn0 = *(const bf16x8*)(qrow), qn1 = *(const bf16x8*)(qrow + 32);
        float sinkn = sinks[hk * 8];
#pragma unroll 1
        for (int hg = 0; hg < 8; ++hg) {
            const int hq = hk * 8 + hg;
            const float slope = exp2f(-0.25f * (float)(hq + 1)); const float sink = sinkn;
            const bf16x8 q0 = qn0, q1 = qn1;
            { const int hn = (hg < 7) ? hg + 1 : 7; qn0 = *(const bf16x8*)(qrow + hn * 64); qn1 = *(const bf16x8*)(qrow + hn * 64 + 32); sinkn = sinks[hk * 8 + hn]; }
            f32x4 sc[10]; float mx = sink;
#pragma unroll
            for (int kh = 0; kh < 2; ++kh) {
            bf16x8 ka_[5], kb_[5];
#pragma unroll
            for (int k5 = 0; k5 < 5 - kh; ++k5) { const LAS unsigned char* p = lds + KS + (16 * (w + 5 * kh + k5) + li) * ROW + 8 * g * 2; ka_[k5] = *(const LAS bf16x8*)p; kb_[k5] = *(const LAS bf16x8*)(p + 64); }
            __builtin_amdgcn_sched_barrier(0);
#pragma unroll
            for (int k5 = 0; k5 < 5 - kh; ++k5) { const int kt = 5 * kh + k5;
                f32x4 s = (f32x4){0.f, 0.f, 0.f, 0.f};
                s = MFMA16(ka_[k5], q0, s); s = MFMA16(kb_[k5], q1, s);
#pragma unroll
                for (int r = 0; r < 4; ++r) { const int j = 4 * g + r; const int dist = 128 + li - 16 * kt - j;
                    bool valid = (kt == 0) ? (j > li) : ((kt == 8) ? (j <= li) : true);
                    if (nb == 0) valid = valid && (16 * (w + kt) + j >= 128);
                    s[r] = valid ? s[r] - slope * (float)dist : -INFINITY; mx = fmaxf(mx, s[r]); }
                sc[kt] = s; }
            __builtin_amdgcn_sched_barrier(0); }
            mx = fmaxf(mx, __shfl_xor(mx, 16)); mx = fmaxf(mx, __shfl_xor(mx, 32));
            float lsum = 0.f;
#pragma unroll
            for (int kt = 0; kt < 9; ++kt)
#pragma unroll
                for (int r = 0; r < 4; ++r) { const float p = __expf(sc[kt][r] - mx); sc[kt][r] = p; lsum += p; }
            sc[9] = (f32x4){0.f, 0.f, 0.f, 0.f};
            lsum += __shfl_xor(lsum, 16); lsum += __shfl_xor(lsum, 32);
            lsum += __expf(sink - mx);
            const float inv = 1.0f / lsum;
            f32x4 oa[4];
#pragma unroll
            for (int dt = 0; dt < 4; ++dt) oa[dt] = (f32x4){0.f, 0.f, 0.f, 0.f};
#pragma unroll
            for (int i = 0; i < 5; ++i) { const bf16x8 pfr = pack8(sc[2 * i], sc[2 * i + 1]); s16x4 va_[4], vb_[4];
#pragma unroll
                for (int dt = 0; dt < 4; ++dt) { const LAS unsigned char* p = lds + VS + (16 * (w + 2 * i) + 4 * g + (li >> 2)) * ROW + (16 * dt + 4 * (li & 3)) * 2; va_[dt] = tr_read(p); vb_[dt] = tr_read(p + 16 * ROW); }
                __builtin_amdgcn_sched_barrier(0);
#pragma unroll
                for (int dt = 0; dt < 4; ++dt) oa[dt] = MFMA16(cat8(va_[dt], vb_[dt]), pfr, oa[dt]);
                __builtin_amdgcn_sched_barrier(0); }
            LAS unsigned char* stg = lds + 2 * 272 * ROW + w * 2304;
#pragma unroll
            for (int dt = 0; dt < 4; ++dt) { v2u o; o.x = pk2(oa[dt][0] * inv, oa[dt][1] * inv); o.y = pk2(oa[dt][2] * inv, oa[dt][3] * inv); *(LAS v2u*)(stg + li * 144 + dt * 32 + g * 8) = o; }
#pragma unroll
            for (int i = 0; i < 2; ++i) { const int row = (lane >> 3) + 8 * i; const v4u x = *(const LAS v4u*)(stg + row * 144 + (lane & 7) * 16);
                *(v4u*)(AO + (size_t)(nb * 128 + 16 * w + row) * DM + hq * 64 + (lane & 7) * 8) = x; }
        }
        LBAR();
    }
}

__device__ __forceinline__ void conv_phase(const bf16* U, const float* cw, const float* cb, bf16* HM, int G, int bid) {
    constexpr int NCG = FF / 8, RSTRIP = 44, NSTRIP = (SEQ + RSTRIP - 1) / RSTRIP, NTASK = NSTRIP * NCG;
    int tid_ = threadIdx.x; asm volatile("" : "+v"(tid_));
    for (int task = bid * 512 + tid_; task < NTASK; task += G * 512) {
        const int cg = task % NCG, rs = task / NCG, j = cg * 8, t0 = rs * RSTRIP;
        float wa[3][8], wb[3][8], ba[8], bb[8];
#pragma unroll
        for (int k = 0; k < 3; ++k)
#pragma unroll
            for (int i = 0; i < 8; ++i) { wa[k][i] = cw[k * FF2 + j + i]; wb[k][i] = cw[k * FF2 + FF + j + i]; }
#pragma unroll
        for (int i = 0; i < 8; ++i) { ba[i] = cb[j + i]; bb[i] = cb[FF + j + i]; }
        v4u a2 = (v4u){0u, 0u, 0u, 0u}, a1 = a2, b2 = a2, b1 = a2;
        if (t0 > 0) { a2 = *(const v4u*)(U + (size_t)(t0 - 2) * FF2 + j); a1 = *(const v4u*)(U + (size_t)(t0 - 1) * FF2 + j);
                      b2 = *(const v4u*)(U + (size_t)(t0 - 2) * FF2 + FF + j); b1 = *(const v4u*)(U + (size_t)(t0 - 1) * FF2 + FF + j); }
        const int t1 = (t0 + RSTRIP < SEQ) ? t0 + RSTRIP : SEQ;
#pragma unroll 8
        for (int t = t0; t < t1; ++t) {
            const v4u a0 = *(const v4u*)(U + (size_t)t * FF2 + j), b0 = *(const v4u*)(U + (size_t)t * FF2 + FF + j);
            float o[8];
#pragma unroll
            for (int i = 0; i < 4; ++i) {
                const float ca0 = ba[2 * i] + wa[0][2 * i] * bf_lo(a2[i]) + wa[1][2 * i] * bf_lo(a1[i]) + wa[2][2 * i] * bf_lo(a0[i]);
                const float ca1 = ba[2 * i + 1] + wa[0][2 * i + 1] * bf_hi(a2[i]) + wa[1][2 * i + 1] * bf_hi(a1[i]) + wa[2][2 * i + 1] * bf_hi(a0[i]);
                const float cb0 = bb[2 * i] + wb[0][2 * i] * bf_lo(b2[i]) + wb[1][2 * i] * bf_lo(b1[i]) + wb[2][2 * i] * bf_lo(b0[i]);
                const float cb1 = bb[2 * i + 1] + wb[0][2 * i + 1] * bf_hi(b2[i]) + wb[1][2 * i + 1] * bf_hi(b1[i]) + wb[2][2 * i + 1] * bf_hi(b0[i]);
                o[2 * i] = ca0 / (1.0f + __expf(-ca0)) * cb0; o[2 * i + 1] = ca1 / (1.0f + __expf(-ca1)) * cb1; }
            v4u w; w.x = pk2(o[0], o[1]); w.y = pk2(o[2], o[3]); w.z = pk2(o[4], o[5]); w.w = pk2(o[6], o[7]);
            *(v4u*)(HM + (size_t)t * FF + j) = w;
            a2 = a1; a1 = a0; b2 = b1; b1 = b0;
        }
    }
}

__device__ __forceinline__ void final_norm_phase(float* out, const float* gain, int G, int bid) {
    int tid_ = threadIdx.x; asm volatile("" : "+v"(tid_));
    const int tid = tid_, lane = tid & 63, wave = tid >> 6; const int gw = bid * 8 + wave, NGW = G * 8;
    for (int m = gw; m < SEQ; m += NGW) {
        f32x4* xr = (f32x4*)(out + (size_t)m * DM) + lane; f32x4 v[8]; float s = 0.f;
#pragma unroll
        for (int j = 0; j < 8; ++j) { v[j] = xr[64 * j]; s += (v[j][0] * v[j][0] + v[j][1] * v[j][1]) + (v[j][2] * v[j][2] + v[j][3] * v[j][3]); }
        s = wave_sum(s); const float rstd = 1.0f / sqrtf(s * (1.0f / DM) + EPS);
#pragma unroll
        for (int j = 0; j < 8; ++j) { const f32x4 gv = *((const f32x4*)gain + lane + 64 * j); xr[64 * j] = v[j] * rstd * gv; }
    }
}

#ifdef NO_PRO
#define PH_PRO(x) do {} while (0)
#else
#define PH_PRO(x) x
#endif
#ifdef NO_GS
#define PH_GS(x) do {} while (0)
#else
#define PH_GS(x) x
#endif
#ifdef NO_GT
#define PH_GT(x) do {} while (0)
#else
#define PH_GT(x) x
#endif
#ifdef NO_GR
#define PH_GR(x) do {} while (0)
#else
#define PH_GR(x) x
#endif
#ifdef NO_RS
#define PH_RS(x) do {} while (0)
#else
#define PH_RS(x) x
#endif
#ifdef NO_RO
#define PH_RO(x) do {} while (0)
#else
#define PH_RO(x) x
#endif
#ifdef NO_CV
#define PH_CV(x) do {} while (0)
#else
#define PH_CV(x) x
#endif
#ifdef NO_AT
#define PH_AT(x) do {} while (0)
#else
#define PH_AT(x) x
#endif
#ifdef NO_FN
#define PH_FN(x) do {} while (0)
#else
#define PH_FN(x) x
#endif
enum { K_PRO = 0, K_GSCALE, K_GSCALET, K_GRESID, K_RSCAN, K_ROUT, K_CONV, K_ATTN, K_FINAL, K_GCONV, K_NONE, K_GRESIDF, K_GRESIDK };
constexpr int NSTEPS = 16;
__global__ void __launch_bounds__(512, 2) fwd_megakernel(Args a) {
    extern __shared__ __attribute__((aligned(16))) unsigned char lds_raw[];
    LAS unsigned char* lds = (LAS unsigned char*)lds_raw;
    cg::grid_group grid = cg::this_grid();
    int G = gridDim.x, bid = blockIdx.x;
    if (threadIdx.x < 16) ((LAS unsigned*)(lds + LDS_CTL_OFF))[threadIdx.x] = 0u;
    __syncthreads();
    XcdBarrier bar = xcd_barrier_post((unsigned*)(a.ws + WS_CTL), (volatile LAS unsigned*)(lds + LDS_CTL_OFF));
    for (int step = a.ph_lo; step < a.ph_hi; ++step) {
        unsigned long long lz = 0; asm volatile("" : "+s"(lz));
        unsigned char* ws = a.ws + lz; float* ss = (float*)(ws + WS_SS); bf16* XB = (bf16*)(ws + WS_XB); bf16* W_RIN = (bf16*)(ws + WS_W_RIN);
        int kind = K_PRO, layer = 0, mode = 0, ldo = 0, cset = 0; bool sync_after = true;
        pg8::Gemm gm{nullptr, nullptr, 0, 0, 0};
        bf16* obf = nullptr; const float* bias = nullptr; const float* rbase = a.out;
        switch (step) {
            case 0: kind = K_PRO; break;
            case 1: kind = K_GSCALE; gm = pg8::Gemm{XB, W_RIN, SEQ, 6144, DM}; obf = (bf16*)(ws + WS_PROJ); ldo = 6144; sync_after = false; break;
            case 2: kind = K_GSCALET; gm = pg8::Gemm{W_RIN + (size_t)6144 * DM, XB, 6144, SEQ, DM}; obf = (bf16*)(ws + WS_KVT); ldo = KVT_LD; break;
            case 3: kind = K_RSCAN; break;
            case 4: kind = K_ROUT; break;
            case 5: kind = K_GRESIDK; gm = pg8::Gemm{(bf16*)(ws + WS_Y), (bf16*)(ws + WS_W_ROUT), SEQ, DM, 4096}; break;
            case 6: kind = K_GCONV; gm = pg8::Gemm{XB - 2 * DM, (bf16*)(ws + WS_W_UP), 33 * 256, FF2, DM, 254}; layer = 0; cset = 1; break;
            case 7: kind = K_NONE; break;
            case 8: kind = K_GRESID; gm = pg8::Gemm{(bf16*)(ws + WS_HM), (bf16*)(ws + WS_W_DN), SEQ, DM, FF}; break;
            case 9: kind = K_GSCALE; gm = pg8::Gemm{XB, (bf16*)(ws + WS_W_QKV), SEQ, AIN, DM}; obf = (bf16*)(ws + WS_QKV); ldo = AIN; mode = 2; bias = a.in[5]; cset = 2; break;
            case 10: kind = K_ATTN; break;
            case 11: kind = K_GRESID; gm = pg8::Gemm{(bf16*)(ws + WS_AO), (bf16*)(ws + WS_W_AOUT), SEQ, DM, DM}; break;
            case 12: kind = K_GCONV; gm = pg8::Gemm{XB - 2 * DM, (bf16*)(ws + WS_W_UP) + (size_t)FF2 * DM, 33 * 256, FF2, DM, 254}; layer = 1; cset = 3; break;
            case 13: kind = K_NONE; break;
            case 14: kind = K_GRESIDF; gm = pg8::Gemm{(bf16*)(ws + WS_HM), (bf16*)(ws + WS_W_DN) + (size_t)DM * FF, SEQ, DM, FF}; sync_after = false; break;
            default: kind = K_NONE; sync_after = false; break;
        }
#ifndef DUP_MASK
#define DUP_MASK 0
#endif
        if (kind == K_NONE) continue;
        for (int rep = 0; rep <= ((DUP_MASK >> step) & 1); ++rep) {
        if (rep) __syncthreads();
        if (kind == K_PRO) { PH_PRO(prologue(a, lds, G, bid)); }
        else if (kind == K_GSCALE) { pg8::StaticOrder S; S.init(gm.M, gm.N, G, bid); pg8::EpiScale E{obf, ldo, ss, bias, mode};
            PH_GS((pg8::gemm_phase<pg8::EpiScale, pg8::StaticOrder, true, true>(lds, gm, S, E)));
            if (cset) { const int rem = S.nwg % G;
                if (rem == 0 || bid >= rem) { int t_ = threadIdx.x; asm volatile("" : "+v"(t_)); const int nw = (rem == 0) ? G : G - rem;
                    convert_set(a, lds, cset, __builtin_amdgcn_readfirstlane(t_ >> 6), t_ & 63, ((rem == 0) ? bid : bid - rem) * 8 + (t_ >> 6), nw * 8); } } }
        else if (kind == K_GSCALET) { pg8::StaticOrder S; S.init(gm.M, gm.N, G, bid); pg8::EpiScaleT E{obf, ldo, ss};
            PH_GT((pg8::gemm_phase<pg8::EpiScaleT, pg8::StaticOrder, true, true>(lds, gm, S, E))); }
        else if (kind == K_GCONV) { pg8::StaticOrder S; S.init(gm.M, gm.N, G, bid); pg8::EpiConv E{(bf16*)(ws + WS_HM), ss, a.in[10] + (size_t)layer * 3 * FF2, a.in[11] + (size_t)layer * FF2};
            pg8::gemm_phase<pg8::EpiConv, pg8::StaticOrder, true, true>(lds, gm, S, E);
            if (cset) { const int rem = S.nwg % G;
                if (rem == 0 || bid >= rem) { int t_ = threadIdx.x; asm volatile("" : "+v"(t_)); const int nw = (rem == 0) ? G : G - rem;
                    convert_set(a, lds, cset, __builtin_amdgcn_readfirstlane(t_ >> 6), t_ & 63, ((rem == 0) ? bid : bid - rem) * 8 + (t_ >> 6), nw * 8); } } }
        else if (kind == K_GRESIDF) { pg8::StaticOrder S; S.init(gm.M, gm.N, G, bid); pg8::EpiResidFinal E{XB, a.out, ss, a.in[13], (unsigned*)(ws + WS_CTL) + 3584, DM};
            pg8::gemm_phase<pg8::EpiResidFinal, pg8::StaticOrder, false, true>(lds, gm, S, E); }
        else if (kind == K_GRESIDK) { pg8::StaticOrder S; S.init(gm.M, gm.N, G, bid); pg8::EpiResidK E{XB, ss, DM, (const float*)(ws + WS_SS + 262144)};
            pg8::gemm_phase<pg8::EpiResidK, pg8::StaticOrder, false, true>(lds, gm, S, E); }
        else if (kind == K_GRESID) { pg8::StaticOrder S; S.init(gm.M, gm.N, G, bid); pg8::EpiResid E{XB, ss, DM};
            PH_GR((pg8::gemm_phase<pg8::EpiResid, pg8::StaticOrder, false, true>(lds, gm, S, E))); }
        else if (kind == K_RSCAN) PH_RS(ret_scan_phase(lds, (const bf16*)(ws + WS_KVT), (bf16*)(ws + WS_ST), G, bid));
        else if (kind == K_ROUT) PH_RO(ret_out_phase(lds, (const bf16*)(ws + WS_PROJ), (const bf16*)(ws + WS_KVT), (const bf16*)(ws + WS_ST), (bf16*)(ws + WS_Y), (float*)(ws + WS_SS + 262144), G, bid));
        else if (kind == K_CONV) PH_CV(conv_phase((const bf16*)(ws + WS_U), a.in[10] + (size_t)layer * 3 * FF2, a.in[11] + (size_t)layer * FF2, (bf16*)(ws + WS_HM), G, bid));
        else if (kind == K_ATTN) PH_AT(attn_phase(lds, (const bf16*)(ws + WS_QKV), a.in[6], (bf16*)(ws + WS_AO), G, bid));
        else { PH_FN(final_norm_phase(a.out, a.in[13], G, bid)); }
        }
        if (step + 1 < a.ph_hi) { if (!sync_after) __syncthreads(); else if (a.ph_hi > NSTEPS) grid.sync(); else xcd_barrier(bar); }
    }
}

extern "C" void kernel_launch(void* const* d_in, const int* in_sizes, int n_in, void* d_out, int out_size, void* d_ws, size_t ws_size, hipStream_t stream) {
    static int grid = 0;
    if (grid == 0) {
        if (n_in != 14 || in_sizes[0] != SEQ * DM || out_size != SEQ * DM || ws_size < WS_END) { fprintf(stderr, "kernel_launch: unexpected shapes / workspace (n_in %d, ws %zu < %zu)\n", n_in, ws_size, (size_t)WS_END); grid = -1; return; }
        int dev = 0, cus = 0, per_cu = 0;
        hipGetDevice(&dev); hipDeviceGetAttribute(&cus, hipDeviceAttributeMultiprocessorCount, dev);
        if (hipFuncSetAttribute((const void*)fwd_megakernel, hipFuncAttributeMaxDynamicSharedMemorySize, LDS_BYTES) != hipSuccess) { fprintf(stderr, "kernel_launch: hipFuncSetAttribute failed\n"); grid = -1; return; }
        if (hipOccupancyMaxActiveBlocksPerMultiprocessor(&per_cu, (const void*)fwd_megakernel, 512, LDS_BYTES) != hipSuccess || per_cu < 1) { fprintf(stderr, "kernel_launch: occupancy query says %d\n", per_cu); per_cu = 1; }
        (void)hipGetLastError();
        grid = cus * per_cu; if (grid > 256) grid = 256;
        if (grid != 256) fprintf(stderr, "kernel_launch: grid %d != 256: the residual GEMM epilogues need one unit per workgroup\n", grid);
    }
    if (grid < 0) return;
    if (hipMemsetAsync((char*)d_ws + WS_CTL, 0, CTL_BYTES, stream) != hipSuccess) { fprintf(stderr, "kernel_launch: memset failed\n"); return; }
    Args a{};
    for (int i = 0; i < 14; ++i) a.in[i] = (const float*)d_in[i];
    a.out = (float*)d_out; a.ws = (unsigned char*)d_ws;
#ifndef MK_SPLIT
    a.ph_lo = 0; a.ph_hi = NSTEPS;
    void* args[] = {&a};
    hipError_t e = hipLaunchCooperativeKernel((const void*)fwd_megakernel, dim3(grid), dim3(512), args, LDS_BYTES, stream);
    if (e != hipSuccess) fprintf(stderr, "cooperative launch failed: %s (grid %d)\n", hipGetErrorString(e), grid);
#else
    static const int cuts[] = {0, 1, 3, 4, 5, 6, 7, 8, 9, 10, 11, 12, 13, 14, 15, 16};
    for (int i = 0; i + 1 < (int)(sizeof(cuts) / sizeof(cuts[0])); ++i) { a.ph_lo = cuts[i]; a.ph_hi = cuts[i + 1]; void* args[] = {&a};
        hipError_t e = hipLaunchCooperativeKernel((const void*)fwd_megakernel, dim3(grid), dim3(512), args, LDS_BYTES, stream);
        if (e != hipSuccess) fprintf(stderr, "cooperative launch %d failed: %s (grid %d)\n", i, hipGetErrorString(e), grid); }
#endif
}
```
